# Optimizing an MI355X kernel written in HIP

```python
import math
import jax
import jax.numpy as jnp
from jax import lax
import numpy as np

D_MODEL = 1024
BATCH = 4
SEQ = 8192
DEPTH = 2

CHUNK = 64
Q_BLOCK = 128
H_A = 8
Q_LORA = 256
KV_LORA = 128
NOPE_DIM = 64
ROPE_DIM = 32
V_DIM_A = 64
ROPE_BASE = 10000.0
H_B = 4
DH_B = 64
T5_BUCKETS = 32
T5_MAX_DIST = 128
H_C = 8
DH_C = 64
H_D = 8
DH_D = 64
BAND_CHUNKS = 8
REL_CLIP = 128
D_FF = 2816
CONV_W = 3
EPS_LN = 1e-5
EPS_RMS = 1e-6
DEEPNORM_ALPHA = (2 * DEPTH) ** 0.25
DEEPNORM_BETA = (8 * DEPTH) ** -0.25
NEG_INF = -1e30

kernel_name = 'hybrid_mla_diff_fox_chunk_convffn'


def layer_norm(x, g, b):
    xf = x.astype(jnp.float32)
    mu = jnp.mean(xf, axis=-1, keepdims=True)
    var = jnp.mean(jnp.square(xf - mu), axis=-1, keepdims=True)
    return ((xf - mu) * lax.rsqrt(var + EPS_LN) * g + b).astype(x.dtype)


def rms_norm(x, g):
    xf = x.astype(jnp.float32)
    ms = jnp.mean(jnp.square(xf), axis=-1, keepdims=True)
    return (xf * lax.rsqrt(ms + EPS_RMS) * g).astype(x.dtype)


def split_cols(h, sizes):
    return jnp.split(h, np.cumsum(sizes)[:-1].tolist(), axis=-1)


def rope_cos_sin(seq_len):
    half = ROPE_DIM // 2
    inv = jnp.power(ROPE_BASE, -jnp.arange(half, dtype=jnp.float32) / half)
    ang = jnp.arange(seq_len, dtype=jnp.float32)[:, None] * inv[None, :]
    return jnp.cos(ang), jnp.sin(ang)


def apply_rope(x, cos, sin):
    half = x.shape[-1] // 2
    x1, x2 = x[..., :half], x[..., half:]
    cos, sin = cos.astype(x.dtype), sin.astype(x.dtype)
    return jnp.concatenate([x1 * cos - x2 * sin, x1 * sin + x2 * cos], axis=-1)


def t5_bucket(rel):
    half = T5_BUCKETS // 2
    max_exact = half // 2
    n = jnp.abs(rel)
    large = max_exact + (jnp.log(jnp.maximum(n, 1).astype(jnp.float32) / max_exact)
                         / math.log(T5_MAX_DIST / max_exact) * (half - max_exact)).astype(jnp.int32)
    large = jnp.minimum(large, half - 1)
    return jnp.where(rel > 0, half, 0) + jnp.where(n < max_exact, n, large)


def chunk_causal_mask(q0, key_idx):
    q_idx = q0 + jnp.arange(Q_BLOCK)
    return (key_idx[None, :] // CHUNK) <= (q_idx[:, None] // CHUNK)


def sweep_blocks(block_fn, n_blocks):
    out = lax.map(block_fn, jnp.arange(n_blocks))
    nb, b, l, h, d = out.shape
    return jnp.moveaxis(out, 0, 1).reshape(b, nb * l, h, d)


def modulate(x, cond, w, b):
    shift, scale, gate = jnp.split(cond @ w + b, 3, axis=-1)
    return x * (1.0 + scale[:, None, :]) + shift[:, None, :], (1.0 + gate)[:, None, :]


def mixer_ab(u, w_in, q_norm, w_uq, kv_norm, w_ukv, lq1, lk1, lq2, lk2, sub_g, t5_table, w_out, layer_idx):
    b, s_len, _ = u.shape
    wb = H_B * 2 * DH_B
    cq, ckv, kr, qb, kb, vb = split_cols(u @ w_in, (Q_LORA, KV_LORA, ROPE_DIM, wb, wb, wb))
    key_idx = jnp.arange(s_len)
    n_blocks = s_len // Q_BLOCK

    cos, sin = rope_cos_sin(s_len)
    qa = (rms_norm(cq, q_norm) @ w_uq).reshape(b, s_len, H_A, NOPE_DIM + ROPE_DIM)
    q_nope = qa[..., :NOPE_DIM]
    q_rope = apply_rope(qa[..., NOPE_DIM:], cos[:, None, :], sin[:, None, :])
    kv = (rms_norm(ckv, kv_norm) @ w_ukv).reshape(b, s_len, H_A, NOPE_DIM + V_DIM_A)
    k_nope, v_a = kv[..., :NOPE_DIM], kv[..., NOPE_DIM:]
    k_rope = apply_rope(kr, cos, sin)
    scale_a = (NOPE_DIM + ROPE_DIM) ** -0.5

    def mla_block(i):
        q0 = i * Q_BLOCK
        qn = lax.dynamic_slice_in_dim(q_nope, q0, Q_BLOCK, axis=1)
        qr = lax.dynamic_slice_in_dim(q_rope, q0, Q_BLOCK, axis=1)
        logits = (jnp.einsum('bqhd,bkhd->bhqk', qn, k_nope, preferred_element_type=jnp.float32)
                  + jnp.einsum('bqhr,bkr->bhqk', qr, k_rope, preferred_element_type=jnp.float32)) * scale_a
        logits = jnp.where(chunk_causal_mask(q0, key_idx), logits, NEG_INF)
        p = jax.nn.softmax(logits, axis=-1).astype(v_a.dtype)
        return jnp.einsum('bhqk,bkhd->bqhd', p, v_a)

    o_a = sweep_blocks(mla_block, n_blocks)

    qd = qb.reshape(b, s_len, H_B, 2, DH_B)
    kd = kb.reshape(b, s_len, H_B, 2, DH_B)
    vd = vb.reshape(b, s_len, H_B, 2 * DH_B)
    lam_init = 0.8 - 0.6 * math.exp(-0.3 * layer_idx)
    lam = (jnp.exp(jnp.sum(lq1.astype(jnp.float32) * lk1.astype(jnp.float32)))
           - jnp.exp(jnp.sum(lq2.astype(jnp.float32) * lk2.astype(jnp.float32))) + lam_init)
    scale_b = DH_B ** -0.5

    def diff_block(i):
        q0 = i * Q_BLOCK
        qq = lax.dynamic_slice_in_dim(qd, q0, Q_BLOCK, axis=1)
        q_idx = q0 + jnp.arange(Q_BLOCK)
        bias = jnp.take(t5_table, t5_bucket(key_idx[None, :] - q_idx[:, None]), axis=1)
        logits = jnp.einsum('bqhcd,bkhcd->bchqk', qq, kd, preferred_element_type=jnp.float32) * scale_b + bias
        logits = jnp.where(chunk_causal_mask(q0, key_idx), logits, NEG_INF)
        p = jax.nn.softmax(logits, axis=-1)
        attn = (p[:, 0] - lam * p[:, 1]).astype(vd.dtype)
        return jnp.einsum('bhqk,bkhd->bqhd', attn, vd)

    o_b = sweep_blocks(diff_block, n_blocks)
    o_b = rms_norm(o_b, sub_g) * (1.0 - lam_init)

    merged = jnp.concatenate([o_a.reshape(b, s_len, H_A * V_DIM_A), o_b.reshape(b, s_len, wb)], axis=-1)
    return merged @ w_out


def mixer_cd(u, w_in, b_f, rel_table, w_out):
    b, s_len, _ = u.shape
    wc, wd = H_C * DH_C, H_D * DH_D
    qc, kc, vc, fl, qd, kd, vd = split_cols(u @ w_in, (wc, wc, wc, H_C, wd, wd, wd))
    qc, kc, vc = (t.reshape(b, s_len, H_C, DH_C) for t in (qc, kc, vc))
    qd, kd, vd = (t.reshape(b, s_len, H_D, DH_D) for t in (qd, kd, vd))
    key_idx = jnp.arange(s_len)

    log_f = jax.nn.log_sigmoid(fl.astype(jnp.float32) + b_f)
    cum_f = jnp.moveaxis(jnp.cumsum(log_f, axis=1), 1, 2)
    scale_c = DH_C ** -0.5

    def fox_block(i):
        q0 = i * Q_BLOCK
        qq = lax.dynamic_slice_in_dim(qc, q0, Q_BLOCK, axis=1)
        fq = lax.dynamic_slice_in_dim(cum_f, q0, Q_BLOCK, axis=2)
        q_idx = q0 + jnp.arange(Q_BLOCK)
        logits = (jnp.einsum('bqhd,bkhd->bhqk', qq, kc, preferred_element_type=jnp.float32) * scale_c
                  + fq[..., :, None] - cum_f[:, :, None, :])
        logits = jnp.where(key_idx[None, :] <= q_idx[:, None], logits, NEG_INF)
        p = jax.nn.softmax(logits, axis=-1).astype(vc.dtype)
        return jnp.einsum('bhqk,bkhd->bqhd', p, vc)

    o_c = sweep_blocks(fox_block, s_len // Q_BLOCK)

    lead = BAND_CHUNKS * CHUNK
    band = lead + CHUNK
    pad = ((0, 0), (lead, 0), (0, 0), (0, 0))
    kp, vp = jnp.pad(kd, pad), jnp.pad(vd, pad)
    kj = jnp.arange(band)
    rel = (lead + jnp.arange(CHUNK))[:, None] - kj[None, :]
    bias_d = jnp.take(rel_table, jnp.clip(rel, -REL_CLIP, REL_CLIP) + REL_CLIP, axis=1)
    scale_d = DH_D ** -0.5

    def chunk_block(ci):
        q0 = ci * CHUNK
        qq = lax.dynamic_slice_in_dim(qd, q0, CHUNK, axis=1)
        kk = lax.dynamic_slice_in_dim(kp, q0, band, axis=1)
        vv = lax.dynamic_slice_in_dim(vp, q0, band, axis=1)
        logits = jnp.einsum('bqhd,bkhd->bhqk', qq, kk, preferred_element_type=jnp.float32) * scale_d + bias_d
        logits = jnp.where((q0 - lead + kj) >= 0, logits, NEG_INF)
        p = jax.nn.softmax(logits, axis=-1).astype(vv.dtype)
        return jnp.einsum('bhqk,bkhd->bqhd', p, vv)

    o_d = sweep_blocks(chunk_block, s_len // CHUNK)

    merged = jnp.concatenate([o_c.reshape(b, s_len, wc), o_d.reshape(b, s_len, wd)], axis=-1)
    return merged @ w_out


def conv_ffn(u, w_gate, w_val, conv_w, conv_b, w_down):
    s_len = u.shape[1]
    g = u @ w_gate
    gp = jnp.pad(g, ((0, 0), (CONV_W - 1, 0), (0, 0)))
    g = sum(conv_w[j] * gp[:, j:j + s_len] for j in range(CONV_W)) + conv_b
    return (jax.nn.silu(g) * (u @ w_val)) @ w_down


def setup_inputs(seed: int = 0) -> dict:
    key = jax.random.key(seed)
    ks = iter(jax.random.split(key, 32))

    def nrm(shape, scale):
        return jax.random.normal(next(ks), shape, jnp.float32) * scale

    d = D_MODEL
    ne, no = (DEPTH + 1) // 2, DEPTH // 2
    in_ab = Q_LORA + KV_LORA + ROPE_DIM + 3 * H_B * 2 * DH_B
    in_cd = 3 * H_C * DH_C + H_C + 3 * H_D * DH_D
    mix_ab = H_A * V_DIM_A + H_B * 2 * DH_B
    mix_cd = H_C * DH_C + H_D * DH_D
    return {
        'x': nrm((BATCH, SEQ, d), 1.0),
        'c': nrm((BATCH, d), 1.0),
        'ada_w': nrm((DEPTH, 2, d, 3 * d), 0.1 * d ** -0.5),
        'ada_b': nrm((DEPTH, 2, 3 * d), 0.01),
        'ln_g': 1.0 + nrm((DEPTH, 2, d), 0.02),
        'ln_b': nrm((DEPTH, 2, d), 0.02),
        't5_table': nrm((H_B, T5_BUCKETS), 0.5),
        'ab_w_in': nrm((ne, d, in_ab), d ** -0.5),
        'mla_q_norm': 1.0 + nrm((ne, Q_LORA), 0.02),
        'mla_w_uq': nrm((ne, Q_LORA, H_A * (NOPE_DIM + ROPE_DIM)), Q_LORA ** -0.5),
        'mla_kv_norm': 1.0 + nrm((ne, KV_LORA), 0.02),
        'mla_w_ukv': nrm((ne, KV_LORA, H_A * (NOPE_DIM + V_DIM_A)), KV_LORA ** -0.5),
        'diff_lq1': nrm((ne, DH_B), 0.1),
        'diff_lk1': nrm((ne, DH_B), 0.1),
        'diff_lq2': nrm((ne, DH_B), 0.1),
        'diff_lk2': nrm((ne, DH_B), 0.1),
        'diff_sub_g': 1.0 + nrm((ne, 2 * DH_B), 0.02),
        'ab_w_out': nrm((ne, mix_ab, d), mix_ab ** -0.5 * DEEPNORM_BETA),
        'cd_w_in': nrm((no, d, in_cd), d ** -0.5),
        'fox_b_f': 3.0 + nrm((no, H_C), 0.5),
        'chunk_rel_table': nrm((no, H_D, 2 * REL_CLIP + 1), 0.5),
        'cd_w_out': nrm((no, mix_cd, d), mix_cd ** -0.5 * DEEPNORM_BETA),
        'ffn_w_gate': nrm((DEPTH, d, D_FF), d ** -0.5),
        'ffn_w_val': nrm((DEPTH, d, D_FF), d ** -0.5),
        'ffn_conv_w': nrm((DEPTH, CONV_W, D_FF), CONV_W ** -0.5),
        'ffn_conv_b': nrm((DEPTH, D_FF), 0.02),
        'ffn_w_down': nrm((DEPTH, D_FF, d), D_FF ** -0.5 * DEEPNORM_BETA),
    }


def reference(x, c, ada_w, ada_b, ln_g, ln_b, t5_table, ab_w_in, mla_q_norm, mla_w_uq, mla_kv_norm,
              mla_w_ukv, diff_lq1, diff_lk1, diff_lq2, diff_lk2, diff_sub_g, ab_w_out, cd_w_in, fox_b_f,
              chunk_rel_table, cd_w_out, ffn_w_gate, ffn_w_val, ffn_conv_w, ffn_conv_b, ffn_w_down):
    cond = jax.nn.silu(c)
    for i in range(DEPTH):
        u, gate = modulate(x, cond, ada_w[i, 0], ada_b[i, 0])
        if i % 2 == 0:
            e = i // 2
            y = mixer_ab(u, ab_w_in[e], mla_q_norm[e], mla_w_uq[e], mla_kv_norm[e], mla_w_ukv[e],
                         diff_lq1[e], diff_lk1[e], diff_lq2[e], diff_lk2[e], diff_sub_g[e], t5_table,
                         ab_w_out[e], i)
        else:
            o = i // 2
            y = mixer_cd(u, cd_w_in[o], fox_b_f[o], chunk_rel_table[o], cd_w_out[o])
        x = layer_norm(DEEPNORM_ALPHA * x + gate * y, ln_g[i, 0], ln_b[i, 0])
        u, gate = modulate(x, cond, ada_w[i, 1], ada_b[i, 1])
        y = conv_ffn(u, ffn_w_gate[i], ffn_w_val[i], ffn_conv_w[i], ffn_conv_b[i], ffn_w_down[i])
        x = layer_norm(DEEPNORM_ALPHA * x + gate * y, ln_g[i, 1], ln_b[i, 1])
    return x
```

```cpp
#include <hip/hip_runtime.h>
#include <hip/hip_cooperative_groups.h>
#include <cstdio>
#include <cstdint>
namespace cg = cooperative_groups;
namespace pg8 {
#define PG8_LAS __attribute__((address_space(3)))
typedef unsigned short bf16_t;
typedef short bf16x8 __attribute__((ext_vector_type(8)));
typedef float f32x4 __attribute__((ext_vector_type(4)));
typedef unsigned u32x4 __attribute__((ext_vector_type(4)));
constexpr int BM = 256, BK = 64, HALF = 128, HTB = HALF * BK * 2  , STAGE_BYTES = 8 * HTB, NXCD = 8, WGM = 8;

__host__ __device__ __forceinline__ int lds_byte(int r, int c) { const int st = (r >> 4) * 2 + (c >> 5), rr = r & 15, cc = c & 31, ob = rr * 64 + cc * 2; return st * 1024 + (ob ^ (((ob >> 9) & 1) << 5)); }
__host__ __device__ __forceinline__ void stage_rc(int b, int& R, int& C) { const int st = b / 1024, sb = b % 1024, swz = sb ^ (((sb >> 9) & 1) << 5); R = (st >> 1) * 16 + swz / 64; C = (st & 1) * 32 + (swz % 64) / 2; }
__host__ __device__ __forceinline__ int perm32(int rho) { const int n = rho >> 4, i = rho & 15; return 8 * (i >> 2) + 4 * n + (i & 3); }

struct Unit { int pm, pn; };
struct Gemm { const bf16_t* A; const bf16_t* Bt; int M, N, K; };

struct StaticOrder {
    int nM, nN, nwg, G, c;
    __host__ __device__ void init(int M, int N, int G_, int c_) { nM = M / BM; nN = N / BM; nwg = nM * nN; G = G_; c = c_; }
    __host__ __device__ bool next(int i, Unit& u) const {
        const long L = (long)i * G + c; if (L >= nwg) return false;
        int wgid = (int)L; { const int q = nwg / NXCD, r = nwg % NXCD, xcd = wgid % NXCD, off = wgid / NXCD; wgid = (xcd < r ? xcd * (q + 1) : r * (q + 1) + (xcd - r) * q) + off; }
        const int nig = WGM * nN, gid = wgid / nig, fm = gid * WGM, gsz = (nM - fm) < WGM ? (nM - fm) : WGM;
        u.pm = fm + ((wgid % nig) % gsz); u.pn = (wgid % nig) / gsz; return true;
    }
    __device__ __forceinline__ void a_ready(const Unit&) const {}
    __device__ __forceinline__ void done(const Unit&) const {}
};

__device__ __forceinline__ unsigned cvt_pk_bf16(float lo, float hi) { unsigned r; asm volatile("v_cvt_pk_bf16_f32 %0, %1, %2" : "=v"(r) : "v"(lo), "v"(hi)); return r; }
typedef float f32x2 __attribute__((ext_vector_type(2)));
__device__ __forceinline__ f32x2 gelu_pk(f32x2 v) {
    const f32x2 av = __builtin_elementwise_abs(v), d = av * 0.2316418882f + 1.0f;
    f32x2 t; t.x = __builtin_amdgcn_rcpf(d.x); t.y = __builtin_amdgcn_rcpf(d.y);
    f32x2 q = t * 0.5307027145f + (-0.7265760135f); q = q * t + 0.7107068705f; q = q * t + (-0.142248368f); q = q * t + 0.127414796f; q = q * t;
    const f32x2 s = (v * v) * (-0.72134752044f);
    f32x2 e; e.x = __builtin_amdgcn_exp2f(s.x); e.y = __builtin_amdgcn_exp2f(s.y);
    const f32x2 m = v * (q * e), r = v - m;
    f32x2 o; o.x = v.x < 0.f ? m.x : r.x; o.y = v.y < 0.f ? m.y : r.y; return o;
}

template <int ACT  > struct EpiBf16 {
    static constexpr bool PERM = true, AFTER_DRAIN = false; static_assert(ACT == 0 || ACT == 1, "EpiBf16: ACT is 0 (none) or 1 (gelu_pk)");
    bf16_t* O; int ldc; const float* bias; int split_cols; size_t split_stride; float scale0;
    __device__ __forceinline__ void operator()(const f32x4 (&acc)[2][2][4][2], const Unit& u, int wr, int wc, int fr, int fq) const {
        const int row0 = u.pm * BM + wr * 64 + fr; int colt = u.pn * BM; bf16_t* base = O;
        float sc = 1.f; if (split_cols) { const int t = colt / split_cols; base += (size_t)t * split_stride; colt -= t * split_cols; if (t == 0) sc = scale0; }
        const int col0 = colt + wc * 32 + 8 * fq, bcol0 = u.pn * BM + wc * 32 + 8 * fq;
        f32x4 bv[2][2];
#pragma unroll
        for (int bj = 0; bj < 2; ++bj)
#pragma unroll
            for (int n = 0; n < 2; ++n) bv[bj][n] = bias ? *(const f32x4*)(bias + bcol0 + bj * HALF + 4 * n) : (f32x4){0.f, 0.f, 0.f, 0.f};
#pragma unroll
        for (int ai = 0; ai < 2; ++ai)
#pragma unroll
            for (int m = 0; m < 4; ++m) { bf16_t* rowp = base + (size_t)(row0 + ai * HALF + m * 16) * ldc + col0;
#pragma unroll
                for (int bj = 0; bj < 2; ++bj) { f32x4 v0 = acc[ai][bj][m][0] + bv[bj][0], v1 = acc[ai][bj][m][1] + bv[bj][1];
                    if (ACT == 1) { f32x2 a = gelu_pk((f32x2){v0[0], v0[1]}), b = gelu_pk((f32x2){v0[2], v0[3]}), c = gelu_pk((f32x2){v1[0], v1[1]}), d = gelu_pk((f32x2){v1[2], v1[3]});
                        v0 = (f32x4){a.x, a.y, b.x, b.y}; v1 = (f32x4){c.x, c.y, d.x, d.y}; }
                    v0 = v0 * sc; v1 = v1 * sc; u32x4 w; w.x = cvt_pk_bf16(v0[0], v0[1]); w.y = cvt_pk_bf16(v0[2], v0[3]); w.z = cvt_pk_bf16(v1[0], v1[1]); w.w = cvt_pk_bf16(v1[2], v1[3]);
                    *(u32x4*)(rowp + bj * HALF) = w; } }
    }
};

struct PanelStats {
    unsigned* xbuf;
    unsigned* cnt;
    unsigned* tmo;
    int ntn; float eps;
    unsigned code;
    __device__ __forceinline__ bool run(const f32x4 (&v)[2][2][4][2], const Unit& u, int wr, int wc, int fr, int fq, PG8_LAS unsigned char* lds, int wid, int lane) const {
        typedef float f32x2v __attribute__((ext_vector_type(2)));
        PG8_LAS f32x2v* P = (PG8_LAS f32x2v*)lds;
        PG8_LAS f32x2v* S = (PG8_LAS f32x2v*)(lds + 8192);
        PG8_LAS unsigned* flag = (PG8_LAS unsigned*)(lds + 8192 + 2048);
#pragma unroll
        for (int ai = 0; ai < 2; ++ai)
#pragma unroll
            for (int m = 0; m < 4; ++m) {
                float s = 0.f;
#pragma unroll
                for (int bj = 0; bj < 2; ++bj)
#pragma unroll
                    for (int n = 0; n < 2; ++n) { const f32x4 x = v[ai][bj][m][n]; s += (x[0] + x[1]) + (x[2] + x[3]); }
                s += __shfl_xor(s, 16); s += __shfl_xor(s, 32);
                const float mw = s * (1.0f / 64.0f); float q = 0.f;
#pragma unroll
                for (int bj = 0; bj < 2; ++bj)
#pragma unroll
                    for (int n = 0; n < 2; ++n) { const f32x4 d = v[ai][bj][m][n] - mw; q += (d[0] * d[0] + d[1] * d[1]) + (d[2] * d[2] + d[3] * d[3]); }
                q += __shfl_xor(q, 16); q += __shfl_xor(q, 32);
                if (fq == 0) P[(ai * HALF + wr * 64 + m * 16 + fr) * 4 + wc] = (f32x2v){mw, q};
            }
        asm volatile("s_waitcnt lgkmcnt(0)" ::: "memory"); __builtin_amdgcn_s_barrier(); asm volatile("" ::: "memory");
#if defined(BROKEN_EXCHANGE_NO_WAIT)
#warning BROKEN CONTROL BUILD: the row-statistics exchange does not wait; results are wrong by design
        if (blockIdx.x >= 64) { const long long t0_ = clock64(); while (clock64() - t0_ < 60000) __builtin_amdgcn_s_sleep(8); }
#endif
        const int row = wid * 32 + (lane & 31);
        if (lane < 32) {
            const f32x2v a = P[row * 4 + 0], b = P[row * 4 + 1], c = P[row * 4 + 2], d = P[row * 4 + 3];
            const float mt = (a.x + b.x + c.x + d.x) * 0.25f;
            const float da = a.x - mt, db = b.x - mt, dc = c.x - mt, dd = d.x - mt;
            const float m2 = (a.y + b.y) + (c.y + d.y) + 64.0f * ((da * da + db * db) + (dc * dc + dd * dd));
            unsigned long long* slot = (unsigned long long*)xbuf + ((size_t)(u.pm * BM + row) * 4 + u.pn);
            __hip_atomic_store(slot, ((unsigned long long)__float_as_uint(m2) << 32) | __float_as_uint(mt), __ATOMIC_RELAXED, __HIP_MEMORY_SCOPE_AGENT);
        }
        asm volatile("s_waitcnt vmcnt(0)" ::: "memory");
        if (lane == 0) __hip_atomic_fetch_add(cnt + 64 * u.pm, 1u, __ATOMIC_RELAXED, __HIP_MEMORY_SCOPE_AGENT);
        if (wid == 0) {
            bool dead = false; const unsigned long long t0 = __builtin_amdgcn_s_memrealtime(); const unsigned want = 8u * (unsigned)ntn;
            for (;;) {
#if defined(BROKEN_EXCHANGE_NO_WAIT)
                break;
#endif
                if ((unsigned)__builtin_amdgcn_readfirstlane(__hip_atomic_load(cnt + 64 * u.pm, __ATOMIC_RELAXED, __HIP_MEMORY_SCOPE_AGENT)) >= want) break;
                if (__builtin_amdgcn_s_memrealtime() - t0 > 2000000ull) {
                    if (lane == 0) { unsigned expect = 0u; __hip_atomic_compare_exchange_strong(tmo + 1, &expect, code | (unsigned)(u.pm & 0xff), __ATOMIC_RELAXED, __ATOMIC_RELAXED, __HIP_MEMORY_SCOPE_AGENT);
                                     __hip_atomic_store(tmo, 1u, __ATOMIC_RELAXED, __HIP_MEMORY_SCOPE_AGENT); }
                    dead = true; break; }
                __builtin_amdgcn_s_sleep(2);
            }
            __builtin_amdgcn_fence(__ATOMIC_ACQUIRE, "agent");
            if (lane == 0) flag[0] = dead ? 1u : 0u;
        }
        asm volatile("s_waitcnt vmcnt(0) lgkmcnt(0)" ::: "memory"); __builtin_amdgcn_s_barrier(); asm volatile("" ::: "memory");
        const bool bad = flag[0] != 0u;
        if (lane < 32) {
            const unsigned long long* slot = (const unsigned long long*)xbuf + (size_t)(u.pm * BM + row) * 4; float mt[4], m2[4]; float ms = 0.f;
#pragma unroll
            for (int t = 0; t < 4; ++t) { if (t < ntn) { const unsigned long long w = __hip_atomic_load(slot + t, __ATOMIC_RELAXED, __HIP_MEMORY_SCOPE_AGENT); mt[t] = __uint_as_float((unsigned)w); m2[t] = __uint_as_float((unsigned)(w >> 32)); } else { mt[t] = 0.f; m2[t] = 0.f; } ms += mt[t]; }
            const float mean = ms / (float)ntn; float q = 0.f;
#pragma unroll
            for (int t = 0; t < 4; ++t) if (t < ntn) { const float dm = mt[t] - mean; q += m2[t] + 256.0f * dm * dm; }
            S[row] = (f32x2v){mean, 1.0f / sqrtf(q / (256.0f * (float)ntn) + eps)};
        }
        asm volatile("s_waitcnt lgkmcnt(0)" ::: "memory"); __builtin_amdgcn_s_barrier(); asm volatile("" ::: "memory");
        return bad;
    }
};
struct EpiLnRes {
    static constexpr bool PERM = false, AFTER_DRAIN = true;
    const float* base; float* out; int ldc; const float* bias; PanelStats st; unsigned poison;
    __device__ __forceinline__ void fused(f32x4 (&acc)[2][2][4][2], const Unit& u, int wr, int wc, int fr, int fq, PG8_LAS unsigned char* lds, int wid, int lane) const {
        typedef float f32x2v __attribute__((ext_vector_type(2)));
        const PG8_LAS f32x2v* S = (const PG8_LAS f32x2v*)(lds + 8192);
        const int col0 = u.pn * BM + wc * 32 + 4 * fq;
#pragma unroll
        for (int bj = 0; bj < 2; ++bj)
#pragma unroll
            for (int n = 0; n < 2; ++n) { const f32x4 bv = bias ? *(const f32x4*)(bias + col0 + bj * HALF + n * 16) : (f32x4){0.f, 0.f, 0.f, 0.f};
#pragma unroll
                for (int ai = 0; ai < 2; ++ai)
#pragma unroll
                    for (int m = 0; m < 4; ++m) acc[ai][bj][m][n] += bv; }
        f32x4 pre[4][2][2];
#pragma unroll
        for (int m = 0; m < 4; ++m) { const size_t off = (size_t)(u.pm * BM + wr * 64 + m * 16 + fr) * ldc + col0;
#pragma unroll
            for (int bj = 0; bj < 2; ++bj)
#pragma unroll
                for (int n = 0; n < 2; ++n) pre[m][bj][n] = *(const f32x4*)(base + off + bj * HALF + n * 16); }
        const bool bad = st.run(acc, u, wr, wc, fr, fq, lds, wid, lane) || poison != 0u;
        const float qnan = __builtin_nanf("");
#pragma unroll
        for (int ai = 0; ai < 2; ++ai)
#pragma unroll
            for (int m = 0; m < 4; ++m) { const int r = ai * HALF + wr * 64 + m * 16 + fr; const f32x2v sr = S[r]; const size_t off = (size_t)(u.pm * BM + r) * ldc + col0;
#pragma unroll
                for (int bj = 0; bj < 2; ++bj)
#pragma unroll
                    for (int n = 0; n < 2; ++n) { const f32x4 bs = ai == 0 ? pre[m][bj][n] : *(const f32x4*)(base + off + bj * HALF + n * 16); f32x4 o = bs + (acc[ai][bj][m][n] - sr.x) * sr.y;
                        if (bad) o = (f32x4){qnan, qnan, qnan, qnan}; *(f32x4*)(out + off + bj * HALF + n * 16) = o; }
                if (m & 1) asm volatile("" ::: "memory"); }
    }
};
struct EpiLnResLn {
    static constexpr bool PERM = false, AFTER_DRAIN = true;
    const float* base; float* out; bf16_t* xn; int ldc; const float* bias; PanelStats st1, st2; unsigned poison;
    __device__ __forceinline__ void fused(f32x4 (&acc)[2][2][4][2], const Unit& u, int wr, int wc, int fr, int fq, PG8_LAS unsigned char* lds, int wid, int lane) const {
        typedef float f32x2v __attribute__((ext_vector_type(2))); typedef unsigned u32x2v __attribute__((ext_vector_type(2)));
        const PG8_LAS f32x2v* S = (const PG8_LAS f32x2v*)(lds + 8192);
        const int col0 = u.pn * BM + wc * 32 + 4 * fq;
#pragma unroll
        for (int bj = 0; bj < 2; ++bj)
#pragma unroll
            for (int n = 0; n < 2; ++n) { const f32x4 bv = bias ? *(const f32x4*)(bias + col0 + bj * HALF + n * 16) : (f32x4){0.f, 0.f, 0.f, 0.f};
#pragma unroll
                for (int ai = 0; ai < 2; ++ai)
#pragma unroll
                    for (int m = 0; m < 4; ++m) acc[ai][bj][m][n] += bv; }
        bool bad = st1.run(acc, u, wr, wc, fr, fq, lds, wid, lane) || poison != 0u;
        const float qnan = __builtin_nanf("");
#pragma unroll
        for (int ai = 0; ai < 2; ++ai)
#pragma unroll
            for (int m = 0; m < 4; ++m) { const int r = ai * HALF + wr * 64 + m * 16 + fr; const f32x2v sr = S[r]; const size_t off = (size_t)(u.pm * BM + r) * ldc + col0;
#pragma unroll
                for (int bj = 0; bj < 2; ++bj)
#pragma unroll
                    for (int n = 0; n < 2; ++n) { const f32x4 bs = *(const f32x4*)(base + off + bj * HALF + n * 16); acc[ai][bj][m][n] = bs + (acc[ai][bj][m][n] - sr.x) * sr.y; }
                asm volatile("" : "+v"(acc[ai][0][m][0]), "+v"(acc[ai][0][m][1]), "+v"(acc[ai][1][m][0]), "+v"(acc[ai][1][m][1]));
                if (m & 1) asm volatile("" ::: "memory"); }
        const bool bad1 = bad;
        bad = st2.run(acc, u, wr, wc, fr, fq, lds, wid, lane) || bad;
#pragma unroll
        for (int ai = 0; ai < 2; ++ai)
#pragma unroll
            for (int m = 0; m < 4; ++m) { const int r = ai * HALF + wr * 64 + m * 16 + fr; const f32x2v sr = S[r]; const size_t off = (size_t)(u.pm * BM + r) * ldc + col0;
#pragma unroll
                for (int bj = 0; bj < 2; ++bj)
#pragma unroll
                    for (int n = 0; n < 2; ++n) { const f32x4 x1 = acc[ai][bj][m][n]; *(f32x4*)(out + off + bj * HALF + n * 16) = bad1 ? (f32x4){qnan, qnan, qnan, qnan} : x1;
                        const f32x4 o = (x1 - sr.x) * sr.y; u32x2v w; w.x = cvt_pk_bf16(o[0], o[1]); w.y = cvt_pk_bf16(o[2], o[3]);
                        if (bad) { w.x = 0x7fc07fc0u; w.y = 0x7fc07fc0u; } *(u32x2v*)(xn + off + bj * HALF + n * 16) = w; }
                asm volatile("" ::: "memory"); }
    }
};

template <class Epi, class Sched, bool ALIGN_EPI = false, bool SP2 = false>
__device__ __forceinline__ void gemm_phase(PG8_LAS unsigned char* lds, const Gemm g, const Sched& S, const Epi& E) {
    const int tid = threadIdx.x, wid = __builtin_amdgcn_readfirstlane(tid >> 6), lane = tid & 63, wr = wid >> 2, wc = wid & 3, fr = lane & 15, fq = lane >> 4;
    const int K = g.K, nt = K / BK;
    unsigned voffA[2], voffB[2];
#pragma unroll
    for (int i = 0; i < 2; ++i) { int R, C; stage_rc(tid * 16 + i * 8192, R, C); const int Rb = Epi::PERM ? ((R & ~31) + perm32(R & 31)) : R;
        voffA[i] = (unsigned)(R * K + C) * 2u; voffB[i] = (unsigned)(Rb * K + C) * 2u; }
    const size_t kstep = (size_t)(BK * 2);
    const size_t hstep = (size_t)HALF * K * 2;
    const size_t tstep = 2 * hstep;
    const unsigned ldsw = (unsigned)wid * 1024u;
    const int aoff = lds_byte(wr * 64 + fr, fq * 8), boff = lds_byte(wc * 32 + fr, fq * 8);
#define PG8_SA(b, h) (((b) * 2 + (h)) * HTB)
#define PG8_SB(b, h) ((4 + (b) * 2 + (h)) * HTB)
#define PG8_STAGE(bufoff, gbase, voff) do { _Pragma("unroll") for (int _i = 0; _i < 2; ++_i) \
        __builtin_amdgcn_global_load_lds((const unsigned*)((const char*)(gbase) + (voff)[_i]), (PG8_LAS unsigned*)(lds + (bufoff) + ldsw + _i * 8192), 16, 0, 0); } while (0)
#define PG8_LDA(dst, b, h) do { _Pragma("unroll") for (int m = 0; m < 4; ++m) _Pragma("unroll") for (int k = 0; k < 2; ++k) dst[m][k] = *(const PG8_LAS bf16x8*)(lds + PG8_SA(b, h) + aoff + m * 2048 + k * 1024); } while (0)
#define PG8_LDB(dst, b, h) do { _Pragma("unroll") for (int n = 0; n < 2; ++n) _Pragma("unroll") for (int k = 0; k < 2; ++k) dst[n][k] = *(const PG8_LAS bf16x8*)(lds + PG8_SB(b, h) + boff + n * 2048 + k * 1024); } while (0)
#define PG8_MMA(ai, bj, At, Bt) do { __builtin_amdgcn_s_setprio(1); _Pragma("unroll") for (int m = 0; m < 4; ++m) _Pragma("unroll") for (int n = 0; n < 2; ++n) _Pragma("unroll") for (int k = 0; k < 2; ++k) \
        acc[ai][bj][m][n] = __builtin_amdgcn_mfma_f32_16x16x32_bf16(Bt[n][k], At[m][k], acc[ai][bj][m][n], 0, 0, 0); __builtin_amdgcn_s_setprio(0); } while (0)
#define PG8_WAIT_V(n) asm volatile("s_waitcnt vmcnt(" #n ")" ::: "memory")
#define PG8_WAIT_L(n) asm volatile("s_waitcnt lgkmcnt(" #n ")" ::: "memory")
#define PG8_BAR __builtin_amdgcn_s_barrier()
#define PG8_SCHED __builtin_amdgcn_sched_barrier(0)
    Unit cur, nxt; int ui = 0;
    if (!S.next(0, cur)) return;
    f32x4 acc[2][2][4][2];
#pragma unroll
    for (int a = 0; a < 2; ++a)
#pragma unroll
        for (int b = 0; b < 2; ++b)
#pragma unroll
            for (int m = 0; m < 4; ++m)
#pragma unroll
                for (int n = 0; n < 2; ++n) acc[a][b][m][n] = (f32x4){0.f, 0.f, 0.f, 0.f};
    bf16x8 At[4][2], B0[2][2], B1[2][2];
    const char* cA = (const char*)g.A + (size_t)cur.pm * tstep; const char* cB = (const char*)g.Bt + (size_t)cur.pn * tstep;
    S.a_ready(cur);
    if constexpr (SP2) {
        PG8_STAGE(PG8_SB(0, 0), cB, voffB); PG8_STAGE(PG8_SB(0, 1), cB + hstep, voffB); PG8_STAGE(PG8_SA(0, 0), cA, voffA); PG8_STAGE(PG8_SA(0, 1), cA + hstep, voffA);
        if (wr == 1) PG8_BAR;
        PG8_WAIT_V(2); PG8_BAR;
        PG8_STAGE(PG8_SB(1, 0), cB + kstep, voffB); PG8_STAGE(PG8_SA(1, 0), cA + kstep, voffA); PG8_STAGE(PG8_SB(1, 1), cB + hstep + kstep, voffB);
        PG8_WAIT_V(6); PG8_BAR;
    } else {
        PG8_STAGE(PG8_SB(0, 0), cB, voffB); PG8_STAGE(PG8_SA(0, 0), cA, voffA); PG8_STAGE(PG8_SB(0, 1), cB + hstep, voffB); PG8_STAGE(PG8_SA(0, 1), cA + hstep, voffA);
        if (wr == 1) PG8_BAR;
        PG8_WAIT_V(4); PG8_BAR;
        PG8_STAGE(PG8_SB(1, 0), cB + kstep, voffB); PG8_STAGE(PG8_SA(1, 0), cA + kstep, voffA); PG8_STAGE(PG8_SB(1, 1), cB + hstep + kstep, voffB);
        PG8_WAIT_V(6); PG8_BAR;
    }
    for (;;) {
        const bool has_next = S.next(ui + 1, nxt);
        const char* nA = has_next ? (const char*)g.A + (size_t)nxt.pm * tstep : cA; const char* nB = has_next ? (const char*)g.Bt + (size_t)nxt.pn * tstep : cB;
        for (int t = 0; t < nt; t += 2) {
            const bool last = (t == nt - 2);
            const char* a1 = cA + (size_t)(t + 1) * kstep;
            const char* a2 = last ? nA : cA + (size_t)(t + 2) * kstep; const char* b2 = last ? nB : cB + (size_t)(t + 2) * kstep;
            const char* a3 = a2 + kstep; const char* b3 = b2 + kstep;
            if (last && has_next) S.a_ready(nxt);
            if constexpr (SP2) {
            PG8_LDB(B0, 0, 0); PG8_LDB(B1, 0, 1); PG8_SCHED; PG8_LDA(At, 0, 0); PG8_STAGE(PG8_SA(1, 1), a1 + hstep, voffA);
            PG8_WAIT_V(8); PG8_WAIT_L(0); PG8_BAR; PG8_MMA(0, 0, At, B0); PG8_MMA(0, 1, At, B1); PG8_BAR; PG8_SCHED;
            PG8_LDA(At, 0, 1); PG8_STAGE(PG8_SB(0, 0), b2, voffB); PG8_STAGE(PG8_SB(0, 1), b2 + hstep, voffB); PG8_STAGE(PG8_SA(0, 0), a2, voffA);
            PG8_WAIT_V(8); PG8_WAIT_L(0); PG8_BAR; PG8_MMA(1, 0, At, B0); PG8_MMA(1, 1, At, B1); PG8_BAR; PG8_SCHED;
            PG8_LDB(B0, 1, 0); PG8_LDB(B1, 1, 1); PG8_SCHED; PG8_LDA(At, 1, 0); PG8_STAGE(PG8_SA(0, 1), a2 + hstep, voffA);
            PG8_WAIT_V(8); PG8_WAIT_L(0); PG8_BAR; PG8_MMA(0, 0, At, B0); PG8_MMA(0, 1, At, B1); PG8_BAR; PG8_SCHED;
            PG8_LDA(At, 1, 1); PG8_STAGE(PG8_SB(1, 0), b3, voffB); PG8_STAGE(PG8_SB(1, 1), b3 + hstep, voffB); PG8_STAGE(PG8_SA(1, 0), a3, voffA);
            PG8_WAIT_V(8); PG8_WAIT_L(0); PG8_BAR; PG8_MMA(1, 0, At, B0); PG8_MMA(1, 1, At, B1); PG8_BAR; PG8_SCHED;
            } else {
            PG8_LDB(B0, 0, 0); PG8_SCHED; PG8_LDA(At, 0, 0); PG8_STAGE(PG8_SA(1, 1), a1 + hstep, voffA);
            PG8_WAIT_L(8); PG8_BAR; PG8_WAIT_L(0); PG8_MMA(0, 0, At, B0); PG8_BAR; PG8_SCHED;
            PG8_LDB(B1, 0, 1); PG8_STAGE(PG8_SB(0, 0), b2, voffB);
            PG8_BAR; PG8_WAIT_L(0); PG8_MMA(0, 1, At, B1); PG8_BAR;
            PG8_LDA(At, 0, 1); PG8_STAGE(PG8_SA(0, 0), a2, voffA);
            PG8_BAR; PG8_WAIT_L(0); PG8_MMA(1, 0, At, B0); PG8_BAR; PG8_SCHED;
            PG8_STAGE(PG8_SB(0, 1), b2 + hstep, voffB);
            PG8_WAIT_V(6); PG8_BAR; PG8_MMA(1, 1, At, B1); PG8_BAR;
            PG8_LDB(B0, 1, 0); PG8_SCHED; PG8_LDA(At, 1, 0); PG8_STAGE(PG8_SA(0, 1), a2 + hstep, voffA);
            PG8_WAIT_L(8); PG8_BAR; PG8_WAIT_L(0); PG8_MMA(0, 0, At, B0); PG8_BAR; PG8_SCHED;
            PG8_LDB(B1, 1, 1); PG8_STAGE(PG8_SB(1, 0), b3, voffB);
            PG8_BAR; PG8_WAIT_L(0); PG8_MMA(0, 1, At, B1); PG8_BAR;
            PG8_LDA(At, 1, 1); PG8_STAGE(PG8_SA(1, 0), a3, voffA);
            PG8_BAR; PG8_WAIT_L(0); PG8_MMA(1, 0, At, B0); PG8_BAR; PG8_SCHED;
            PG8_STAGE(PG8_SB(1, 1), b3 + hstep, voffB);
            PG8_WAIT_V(6); PG8_BAR; PG8_MMA(1, 1, At, B1); PG8_BAR;
            }
        }
        if constexpr (ALIGN_EPI) { if (wr == 0) PG8_BAR; }
        if constexpr (!Epi::AFTER_DRAIN) { E(acc, cur, wr, wc, fr, fq); S.done(cur); }
        if (!has_next) break;
#pragma unroll
        for (int a = 0; a < 2; ++a)
#pragma unroll
            for (int b = 0; b < 2; ++b)
#pragma unroll
                for (int m = 0; m < 4; ++m)
#pragma unroll
                    for (int n = 0; n < 2; ++n) acc[a][b][m][n] = (f32x4){0.f, 0.f, 0.f, 0.f};
        cur = nxt; cA = nA; cB = nB; ++ui;
        if constexpr (ALIGN_EPI) { if (wr == 1) PG8_BAR; }
    }
    PG8_WAIT_V(0);
    if constexpr (!ALIGN_EPI) { if (wr == 0) PG8_BAR; }
    PG8_BAR;
    if constexpr (Epi::AFTER_DRAIN) { E.fused(acc, cur, wr, wc, fr, fq, lds, wid, lane); S.done(cur); }
#undef PG8_SA
#undef PG8_SB
#undef PG8_STAGE
#undef PG8_LDA
#undef PG8_LDB
#undef PG8_MMA
#undef PG8_WAIT_V
#undef PG8_WAIT_L
#undef PG8_BAR
#undef PG8_SCHED
}
}

#define LAS __attribute__((address_space(3)))
typedef unsigned short bf16;
typedef unsigned u32x4 __attribute__((ext_vector_type(4)));
typedef unsigned u32x2 __attribute__((ext_vector_type(2)));
typedef float f32x4 __attribute__((ext_vector_type(4)));
typedef float f32x2 __attribute__((ext_vector_type(2)));
typedef float f32x16 __attribute__((ext_vector_type(16)));
typedef short bf16x8 __attribute__((ext_vector_type(8)));
typedef short s16x4 __attribute__((ext_vector_type(4)));
typedef __bf16 bf16x2_t __attribute__((ext_vector_type(2)));
#define DI __device__ __forceinline__

DI unsigned pk2(float lo, float hi) { f32x2 v = {lo, hi}; bf16x2_t b = __builtin_convertvector(v, bf16x2_t); return __builtin_bit_cast(unsigned, b); }
DI float bflo(unsigned u) { return __uint_as_float(u << 16); }
DI float bfhi(unsigned u) { return __uint_as_float(u & 0xffff0000u); }
DI float wave_sum(float v) {
#pragma unroll
    for (int o = 1; o < 64; o <<= 1) v += __shfl_xor(v, o);
    return v;
}

constexpr int NB = 4, SEQ = 8192, DM = 1024, MROWS = NB * SEQ, DFF = 2816;
constexpr float LOG2E = 1.4426950408889634f;
constexpr float SC_A = 0.14724444602590306f;
constexpr float SC_64 = 0.18033688011112042f;
constexpr float ALPHA = 1.4142135623730951f;
constexpr int NWAVES = 8, NTHR = 512;
constexpr int LDS_BYTES = 147456;

constexpr size_t MiB = 1u << 20;
constexpr size_t WS_MOD = 0;
constexpr size_t WS_MISC = 256 * 1024;
constexpr size_t WS_ROPE = 1 * MiB;
constexpr size_t WS_LF = 2 * MiB;
constexpr size_t WS_F = 3 * MiB;
constexpr size_t W_ABIN = 8 * MiB, W_UQ = 12 * MiB, W_UKV = 12 * MiB + 512 * 1024, W_ABOUT = 13 * MiB, W_CDIN = 15 * MiB, W_CDOUT = 21 * MiB;
constexpr size_t W_UP0 = 23 * MiB, W_UP1 = 34 * MiB, W_DN0 = 45 * MiB, W_DN1 = 51 * MiB;
constexpr size_t WS_U = 64 * MiB;
constexpr size_t WS_R1 = 128 * MiB, WS_R2 = 304 * MiB;
constexpr size_t WS_Y1 = WS_R1;
constexpr size_t WS_QA = 256 * MiB;
constexpr size_t WS_KV = 304 * MiB;
constexpr size_t WS_CQN = 368 * MiB, WS_CKVN = 384 * MiB, WS_KROPE = 392 * MiB;
constexpr size_t WS_G = WS_R1, WS_H = WS_R2;
constexpr size_t WS_QKV1 = WS_R1;
constexpr size_t WS_MRG1 = 320 * MiB;
constexpr size_t WS_END = 480 * MiB;

struct Params { const float* in[27]; float* out; unsigned char* ws; int lo, hi; };

__constant__ float INVF[16] = {1.0f, 0.5623413324356079f, 0.3162277638912201f, 0.17782793939113617f, 0.10000000149011612f, 0.05623413249850273f, 0.03162277489900589f,
    0.017782794311642647f, 0.009999999776482582f, 0.005623413249850273f, 0.003162277629598975f, 0.0017782794311642647f, 0.0010000000474974513f, 0.000562341301701963f,
    0.0003162277571391314f, 0.00017782794020604342f};

DI void tr_item(const float* W, int K, int Nsrc, int srccol0, bf16* WT, int n0, int k0, float sc, LAS float* scr, int lane) {
#pragma unroll 8
    for (int i = 0; i < 32; ++i) { const int kk = 2 * i + (lane >> 5);
        const float v = (srccol0 >= 0) ? W[(size_t)(k0 + kk) * Nsrc + srccol0 + (lane & 31)] : 0.f; scr[kk * 33 + (lane & 31)] = v * sc; }
    asm volatile("s_waitcnt lgkmcnt(0)" ::: "memory");
    const int c = lane & 7;
#pragma unroll
    for (int j = 0; j < 4; ++j) { const int n = (lane >> 3) + 8 * j; const LAS float* s = scr + (8 * c) * 33 + n;
        u32x4 o; o.x = pk2(s[0 * 33], s[1 * 33]); o.y = pk2(s[2 * 33], s[3 * 33]); o.z = pk2(s[4 * 33], s[5 * 33]); o.w = pk2(s[6 * 33], s[7 * 33]);
        *(u32x4*)(WT + (size_t)(n0 + n) * K + k0 + 8 * c) = o; }
    asm volatile("s_waitcnt lgkmcnt(0)" ::: "memory");
}

DI void p_prologue(const Params& p, LAS unsigned char* lds) {
    const int tid = threadIdx.x, lane = tid & 63, wave = tid >> 6, G = gridDim.x, bx = blockIdx.x;
    const float* c = p.in[1]; const float* ada_w = p.in[2]; const float* ada_b = p.in[3];
    float* MOD = (float*)(p.ws + WS_MOD);
    LAS float* cond = (LAS float*)lds;
    LAS float* red = (LAS float*)(lds + 16384);
    for (int i = tid; i < 4096; i += NTHR) { const float v = c[i]; cond[i] = v / (1.f + __expf(-v)); }
    __syncthreads();
    for (int it = bx; it < 192; it += G) {
        const int sub = it / 48, cb = it % 48, col = cb * 64 + lane;
        const float* w = ada_w + (size_t)sub * 1024 * 3072 + col;
        float a0 = 0.f, a1 = 0.f, a2 = 0.f, a3 = 0.f; const int kb = wave * 128;
#pragma unroll 8
        for (int k = 0; k < 128; ++k) { const float wv = w[(size_t)(kb + k) * 3072];
            a0 += cond[kb + k] * wv; a1 += cond[1024 + kb + k] * wv; a2 += cond[2048 + kb + k] * wv; a3 += cond[3072 + kb + k] * wv; }
        red[(wave * 4 + 0) * 64 + lane] = a0; red[(wave * 4 + 1) * 64 + lane] = a1; red[(wave * 4 + 2) * 64 + lane] = a2; red[(wave * 4 + 3) * 64 + lane] = a3;
        __syncthreads();
        if (tid < 256) { const int b = tid >> 6; float s = 0.f;
#pragma unroll
            for (int w8 = 0; w8 < 8; ++w8) s += red[(w8 * 4 + b) * 64 + lane];
            s += ada_b[sub * 3072 + col]; if (col >= 1024) s += 1.f;
            MOD[(sub * 4 + b) * 3072 + col] = s; }
        __syncthreads();
    }
    LAS float* scr = (LAS float*)(lds + 32768 + wave * 8448);
    const int gw = bx * NWAVES + wave, NGW = G * NWAVES;
    constexpr int NITEMS = 1024 + 96 + 64 + 512 + 1536 + 512 + 4 * 1408 + 2 * 1408;
    for (int it = gw; it < NITEMS; it += NGW) {
        int r = it; int job = 0;
        const int cnt[12] = {1024, 96, 64, 512, 1536, 512, 1408, 1408, 1408, 1408, 1408, 1408};
#pragma unroll
        for (int j = 0; j < 11; ++j) { if (job == j && r >= cnt[j]) { r -= cnt[j]; job = j + 1; } }
        const float* W; int K, Nsrc, Ndst; bf16* WT;
        switch (job) {
            case 0: W = p.in[7]; K = 1024; Nsrc = 1952; Ndst = 2048; WT = (bf16*)(p.ws + W_ABIN); break;
            case 1: W = p.in[9]; K = 256; Nsrc = 768; Ndst = 768; WT = (bf16*)(p.ws + W_UQ); break;
            case 2: W = p.in[11]; K = 128; Nsrc = 1024; Ndst = 1024; WT = (bf16*)(p.ws + W_UKV); break;
            case 3: W = p.in[17]; K = 1024; Nsrc = 1024; Ndst = 1024; WT = (bf16*)(p.ws + W_ABOUT); break;
            case 4: W = p.in[18]; K = 1024; Nsrc = 3080; Ndst = 3072; WT = (bf16*)(p.ws + W_CDIN); break;
            case 5: W = p.in[21]; K = 1024; Nsrc = 1024; Ndst = 1024; WT = (bf16*)(p.ws + W_CDOUT); break;
            case 6: W = p.in[22]; K = 1024; Nsrc = 2816; Ndst = 2816; WT = (bf16*)(p.ws + W_UP0); break;
            case 7: W = p.in[23]; K = 1024; Nsrc = 2816; Ndst = 2816; WT = (bf16*)(p.ws + W_UP0) + (size_t)2816 * 1024; break;
            case 8: W = p.in[22] + (size_t)1024 * 2816; K = 1024; Nsrc = 2816; Ndst = 2816; WT = (bf16*)(p.ws + W_UP1); break;
            case 9: W = p.in[23] + (size_t)1024 * 2816; K = 1024; Nsrc = 2816; Ndst = 2816; WT = (bf16*)(p.ws + W_UP1) + (size_t)2816 * 1024; break;
            case 10: W = p.in[26]; K = 2816; Nsrc = 1024; Ndst = 1024; WT = (bf16*)(p.ws + W_DN0); break;
            default: W = p.in[26] + (size_t)2816 * 1024; K = 2816; Nsrc = 1024; Ndst = 1024; WT = (bf16*)(p.ws + W_DN1); break;
        }
        const int nblk = Ndst / 32, kb = r / nblk, nb = r % nblk, n0 = nb * 32, k0 = kb * 64;
        int src = n0; float sc = 1.f;
        if (job == 0) { src = (n0 < 1952) ? n0 : -1; if (n0 >= 416 && n0 < 928) sc = SC_64; }
        else if (job == 1) { src = (n0 < 512) ? (n0 >> 6) * 96 + (n0 & 63) : ((n0 - 512) >> 5) * 96 + 64; sc = SC_A; }
        else if (job == 2) { src = (n0 < 512) ? (n0 >> 6) * 128 + (n0 & 63) : ((n0 - 512) >> 6) * 128 + 64 + ((n0 - 512) & 63); }
        else if (job == 4) { src = (n0 < 1536) ? n0 : n0 + 8; if (n0 < 512 || (n0 >= 1536 && n0 < 2048)) sc = SC_64; }
        tr_item(W, K, Nsrc, src, WT, n0, k0, sc, scr, lane);
    }
    float* ROPE = (float*)(p.ws + WS_ROPE);
    for (int i = bx * NTHR + tid; i < SEQ * 16; i += G * NTHR) {
        const int pos = i >> 4, fi = i & 15;
        const float ang = (float)pos * INVF[fi];
        const double a = (double)ang, TWO_PI = 6.283185307179586476925;
        const double n = __builtin_rint(a * (1.0 / TWO_PI));
        const double x = a - n * TWO_PI, x2 = x * x;
        double sn = 1.0, cs = 1.0;
#pragma unroll
        for (int k = 13; k >= 1; --k) { sn = 1.0 - sn * x2 / (double)((2 * k) * (2 * k + 1)); cs = 1.0 - cs * x2 / (double)((2 * k - 1) * (2 * k)); }
        ROPE[i] = (float)cs; ROPE[SEQ * 16 + i] = (float)(sn * x);
    }
    if (bx == 0 && tid == 0) {
        float d1 = 0.f, d2 = 0.f;
        for (int i = 0; i < 64; ++i) { d1 += p.in[12][i] * p.in[13][i]; d2 += p.in[14][i] * p.in[15][i]; }
        ((float*)(p.ws + WS_MISC))[0] = expf(d1) - expf(d2) + 0.2f;
    }
}

DI void p_modulate(const Params& p) {
    const int tid = threadIdx.x, lane = tid & 63, wave = tid >> 6;
    const int gw = blockIdx.x * NWAVES + wave, NGW = gridDim.x * NWAVES;
    const float* x = p.in[0]; const float* MOD = (const float*)(p.ws + WS_MOD); bf16* U = (bf16*)(p.ws + WS_U);
    for (int row = gw; row < MROWS; row += NGW) {
        const int b = row >> 13; const float* mb = MOD + (size_t)b * 3072;
#pragma unroll
        for (int j = 0; j < 4; ++j) { const int col = 4 * lane + 256 * j;
            const f32x4 v = *(const f32x4*)(x + (size_t)row * DM + col), sh = *(const f32x4*)(mb + col), sc = *(const f32x4*)(mb + 1024 + col);
            const f32x4 u = v * sc + sh; u32x2 o; o.x = pk2(u[0], u[1]); o.y = pk2(u[2], u[3]);
            *(u32x2*)(U + (size_t)row * DM + col) = o; }
    }
}

DI void p_norm3(const Params& p) {
    const int tid = threadIdx.x, lane = tid & 63, wave = tid >> 6;
    const int gw = blockIdx.x * NWAVES + wave, NGW = gridDim.x * NWAVES;
    const bf16* Y1 = (const bf16*)(p.ws + WS_Y1); bf16* CQN = (bf16*)(p.ws + WS_CQN); bf16* CKVN = (bf16*)(p.ws + WS_CKVN); bf16* KR = (bf16*)(p.ws + WS_KROPE);
    const float* ROPE = (const float*)(p.ws + WS_ROPE);
    const f32x4 qg = *(const f32x4*)(p.in[8] + 4 * lane); const f32x2 kg = *(const f32x2*)(p.in[10] + 2 * lane);
    for (int row = gw; row < MROWS; row += NGW) {
        const bf16* yr = Y1 + (size_t)row * 2048;
        const u32x2 a = *(const u32x2*)(yr + 4 * lane); const unsigned kvv = *(const unsigned*)(yr + 256 + 2 * lane);
        float v0 = bflo(a.x), v1 = bfhi(a.x), v2 = bflo(a.y), v3 = bfhi(a.y);
        float ss = wave_sum(v0 * v0 + v1 * v1 + v2 * v2 + v3 * v3);
        float rs = 1.0f / sqrtf(ss * (1.f / 256.f) + 1e-6f);
        u32x2 o; o.x = pk2(v0 * rs * qg[0], v1 * rs * qg[1]); o.y = pk2(v2 * rs * qg[2], v3 * rs * qg[3]);
        *(u32x2*)(CQN + (size_t)row * 256 + 4 * lane) = o;
        float w0 = bflo(kvv), w1 = bfhi(kvv);
        ss = wave_sum(w0 * w0 + w1 * w1); rs = 1.0f / sqrtf(ss * (1.f / 128.f) + 1e-6f);
        *(unsigned*)(CKVN + (size_t)row * 128 + 2 * lane) = pk2(w0 * rs * kg[0], w1 * rs * kg[1]);
        if (lane < 16) { const int pos = row & (SEQ - 1);
            const float x1 = bflo((unsigned)yr[384 + lane]), x2 = bflo((unsigned)yr[400 + lane]);
            const float cs = ROPE[pos * 16 + lane], sn = ROPE[SEQ * 16 + pos * 16 + lane];
            KR[(size_t)row * 32 + lane] = (bf16)(pk2(x1 * cs - x2 * sn, 0.f) & 0xffffu);
            KR[(size_t)row * 32 + 16 + lane] = (bf16)(pk2(x1 * sn + x2 * cs, 0.f) & 0xffffu); }
    }
}

DI void p_ln(const Params& p, int lnidx, int next_sub, bool do_fl) {
    const int tid = threadIdx.x, lane = tid & 63, wave = tid >> 6;
    const int gw = blockIdx.x * NWAVES + wave, NGW = gridDim.x * NWAVES;
    float* X = p.out; const float* g = p.in[4] + lnidx * 1024; const float* bt = p.in[5] + lnidx * 1024;
    const float* MOD = (const float*)(p.ws + WS_MOD); bf16* U = (bf16*)(p.ws + WS_U);
    const float* wf = p.in[18] + 1536; const float* bfv = p.in[19]; float* LF = (float*)(p.ws + WS_LF);
    for (int row = gw; row < MROWS; row += NGW) {
        const int b = row >> 13;
        f32x4 v[4]; float s = 0.f;
#pragma unroll
        for (int j = 0; j < 4; ++j) { v[j] = *(const f32x4*)(X + (size_t)row * DM + 4 * lane + 256 * j); s += (v[j][0] + v[j][1]) + (v[j][2] + v[j][3]); }
        const float mean = wave_sum(s) * (1.f / 1024.f); float s2 = 0.f;
#pragma unroll
        for (int j = 0; j < 4; ++j) { v[j] = v[j] - mean; s2 += (v[j][0] * v[j][0] + v[j][1] * v[j][1]) + (v[j][2] * v[j][2] + v[j][3] * v[j][3]); }
        const float rstd = 1.0f / sqrtf(wave_sum(s2) * (1.f / 1024.f) + 1e-5f);
        float fa[8] = {0.f, 0.f, 0.f, 0.f, 0.f, 0.f, 0.f, 0.f};
#pragma unroll
        for (int j = 0; j < 4; ++j) { const int col = 4 * lane + 256 * j;
            const f32x4 xn = v[j] * rstd * *(const f32x4*)(g + col) + *(const f32x4*)(bt + col);
            *(f32x4*)(X + (size_t)row * DM + col) = xn;
            if (next_sub >= 0) { const float* mb = MOD + (size_t)(next_sub * 4 + b) * 3072;
                const f32x4 u = xn * *(const f32x4*)(mb + 1024 + col) + *(const f32x4*)(mb + col);
                u32x2 o; o.x = pk2(u[0], u[1]); o.y = pk2(u[2], u[3]); *(u32x2*)(U + (size_t)row * DM + col) = o;
                if (do_fl) {
#pragma unroll
                    for (int e = 0; e < 4; ++e) { const f32x4 w0 = *(const f32x4*)(wf + (size_t)(col + e) * 3080), w1 = *(const f32x4*)(wf + (size_t)(col + e) * 3080 + 4);
                        fa[0] += u[e] * w0[0]; fa[1] += u[e] * w0[1]; fa[2] += u[e] * w0[2]; fa[3] += u[e] * w0[3];
                        fa[4] += u[e] * w1[0]; fa[5] += u[e] * w1[1]; fa[6] += u[e] * w1[2]; fa[7] += u[e] * w1[3]; } } }
        }
        if (do_fl) {
#pragma unroll
            for (int h = 0; h < 8; ++h) fa[h] = wave_sum(fa[h]);
            if (lane < 8) {
                float xv = fa[0];
#pragma unroll
                for (int h = 1; h < 8; ++h) xv = (lane == h) ? fa[h] : xv;
                xv += bfv[lane];
                const float lf = fminf(xv, 0.f) - log1pf(expf(-fabsf(xv)));
                LF[(size_t)(b * 8 + lane) * SEQ + (row & (SEQ - 1))] = lf; }
        }
    }
}

DI void p_conv(const Params& p, int layer) {
    const bf16* Gb = (const bf16*)(p.ws + WS_G); bf16* Hb = (bf16*)(p.ws + WS_H);
    const float* cw = p.in[24] + (size_t)layer * 3 * DFF; const float* cbv = p.in[25] + (size_t)layer * DFF;
    const int total = (MROWS / 32) * (DFF / 8);
    for (int it = blockIdx.x * NTHR + threadIdx.x; it < total; it += gridDim.x * NTHR) {
        const int rb = it / (DFF / 8), ch = it % (DFF / 8), row0 = rb * 32, c0 = ch * 8;
        float w0[8], w1[8], w2[8], cb[8], gm2[8], gm1[8];
#pragma unroll
        for (int h = 0; h < 2; ++h) { const f32x4 a = *(const f32x4*)(cw + c0 + 4 * h), b = *(const f32x4*)(cw + DFF + c0 + 4 * h), c = *(const f32x4*)(cw + 2 * DFF + c0 + 4 * h), d = *(const f32x4*)(cbv + c0 + 4 * h);
#pragma unroll
            for (int e = 0; e < 4; ++e) { w0[4 * h + e] = a[e]; w1[4 * h + e] = b[e]; w2[4 * h + e] = c[e]; cb[4 * h + e] = d[e]; } }
        if ((row0 & (SEQ - 1)) == 0) {
#pragma unroll
            for (int e = 0; e < 8; ++e) { gm2[e] = 0.f; gm1[e] = 0.f; }
        } else {
            const u32x4 a = *(const u32x4*)(Gb + (size_t)(row0 - 2) * DFF + c0), b = *(const u32x4*)(Gb + (size_t)(row0 - 1) * DFF + c0);
#pragma unroll
            for (int e = 0; e < 4; ++e) { gm2[2 * e] = bflo(a[e]); gm2[2 * e + 1] = bfhi(a[e]); gm1[2 * e] = bflo(b[e]); gm1[2 * e + 1] = bfhi(b[e]); }
        }
#pragma unroll 4
        for (int r = 0; r < 32; ++r) {
            const size_t off = (size_t)(row0 + r) * DFF + c0;
            const u32x4 gv = *(const u32x4*)(Gb + off), vv = *(const u32x4*)(Hb + off);
            float g0[8], hv[8];
#pragma unroll
            for (int e = 0; e < 4; ++e) { g0[2 * e] = bflo(gv[e]); g0[2 * e + 1] = bfhi(gv[e]); }
#pragma unroll
            for (int e = 0; e < 8; ++e) { const float pre = w0[e] * gm2[e] + w1[e] * gm1[e] + w2[e] * g0[e] + cb[e];
                const float sl = pre * __builtin_amdgcn_rcpf(1.f + __expf(-pre)); const float vval = (e & 1) ? bfhi(vv[e >> 1]) : bflo(vv[e >> 1]);
                hv[e] = sl * vval; gm2[e] = gm1[e]; gm1[e] = g0[e]; }
            u32x4 o; o.x = pk2(hv[0], hv[1]); o.y = pk2(hv[2], hv[3]); o.z = pk2(hv[4], hv[5]); o.w = pk2(hv[6], hv[7]);
            *(u32x4*)(Hb + off) = o;
        }
    }
}

DI void p_scan(const Params& p, LAS unsigned char* lds) {
    if (blockIdx.x >= 32) return;
    const int tid = threadIdx.x, lane = tid & 63, wave = tid >> 6;
    const float* LF = (const float*)(p.ws + WS_LF) + (size_t)blockIdx.x * SEQ; float* F = (float*)(p.ws + WS_F) + (size_t)blockIdx.x * SEQ;
    LAS float* wsum = (LAS float*)lds;
    f32x4 v[4]; float s = 0.f;
#pragma unroll
    for (int j = 0; j < 4; ++j) { v[j] = *(const f32x4*)(LF + tid * 16 + 4 * j);
#pragma unroll
        for (int e = 0; e < 4; ++e) { s += v[j][e]; v[j][e] = s; } }
    float inc = s;
#pragma unroll
    for (int o = 1; o < 64; o <<= 1) { const float t = __shfl_up(inc, o); if (lane >= o) inc += t; }
    if (lane == 63) wsum[wave] = inc;
    __syncthreads();
    float off = inc - s;
#pragma unroll
    for (int w = 0; w < 8; ++w) off += (w < wave) ? wsum[w] : 0.f;
#pragma unroll
    for (int j = 0; j < 4; ++j) *(f32x4*)(F + tid * 16 + 4 * j) = v[j] + off;
    __syncthreads();
}

struct EpiResid {
    static constexpr bool PERM = true, AFTER_DRAIN = false;
    const float* xin; float* xout; const float* gate;
    __device__ __forceinline__ void operator()(const pg8::f32x4 (&acc)[2][2][4][2], const pg8::Unit& u, int wr, int wc, int fr, int fq) const {
        const int row0 = u.pm * 256 + wr * 64 + fr, col0 = u.pn * 256 + wc * 32 + 8 * fq, b = (u.pm * 256) >> 13;
        f32x4 gv[2][2];
#pragma unroll
        for (int bj = 0; bj < 2; ++bj)
#pragma unroll
            for (int n = 0; n < 2; ++n) gv[bj][n] = *(const f32x4*)(gate + (size_t)b * 3072 + col0 + bj * 128 + 4 * n);
#pragma unroll
        for (int ai = 0; ai < 2; ++ai)
#pragma unroll
            for (int m = 0; m < 4; ++m) { const size_t off = (size_t)(row0 + ai * 128 + m * 16) * DM + col0;
#pragma unroll
                for (int bj = 0; bj < 2; ++bj)
#pragma unroll
                    for (int n = 0; n < 2; ++n) { const f32x4 xi = *(const f32x4*)(xin + off + bj * 128 + 4 * n);
                        const f32x4 o = xi * ALPHA + gv[bj][n] * acc[ai][bj][m][n]; *(f32x4*)(xout + off + bj * 128 + 4 * n) = o; } }
    }
};

namespace att {
constexpr int KBUF = 64 * 208, VBUF = 64 * 272;
constexpr int OFF_K = 0, OFF_V = 2 * KBUF, OFF_KB = 2 * KBUF + 2 * VBUF, OFF_TAB = OFF_KB + 512, LDS_END = OFF_TAB + 1024;
constexpr float NEG = -1e30f;
struct Src { const float* rope; const bf16* q; const bf16* q2; int qpitch; const bf16* k; const bf16* k2; int kpitch; const bf16* v; int vpitch; const float* f; float fref; };
#define MFMA32(a, b, c) __builtin_amdgcn_mfma_f32_32x32x16_bf16((a), (b), (c), 0, 0, 0)
typedef short v4i16_t __attribute__((ext_vector_type(4)));
DI s16x4 vtr(LAS unsigned char* ptr) { return __builtin_bit_cast(s16x4, __builtin_amdgcn_ds_read_tr16_b64_v4i16((LAS v4i16_t*)ptr)); }

template <int DQK, int DV, int MODE>
DI void core(LAS unsigned char* lds, const Src& s, int q0, int TLO, int THI, int tlo_w, int thi_w, int near_lo, float farc, f32x16 (&o)[DV / 32], float& l_out) {
    constexpr int KROW = DQK * 2 + 16, VROW = DV * 2 + 16, ND = DQK / 16, NC = DV / 32;
    const int tid = threadIdx.x, lane = tid & 63, r = lane & 31, h = lane >> 5;
    const int wid = __builtin_amdgcn_readfirstlane(tid >> 6);
    bf16x8 qf[ND];
    { const bf16* qp = s.q + (size_t)(q0 + 32 * wid + r) * s.qpitch + 8 * h;
#pragma unroll
      for (int d0 = 0; d0 < 4; ++d0) qf[d0] = *(const bf16x8*)(qp + 16 * d0);
      if constexpr (DQK == 96) { const bf16* q2p = s.q2 + (size_t)(q0 + 32 * wid + r) * s.qpitch + 8 * h;
          const u32x4 x1 = *(const u32x4*)(q2p), x2 = *(const u32x4*)(q2p + 16);
          const float* rp = s.rope + (size_t)(q0 + 32 * wid + r) * 16 + 8 * h;
          const f32x4 c0 = *(const f32x4*)(rp), c1 = *(const f32x4*)(rp + 4), s0 = *(const f32x4*)(rp + SEQ * 16), s1 = *(const f32x4*)(rp + SEQ * 16 + 4);
          u32x4 y1, y2;
#pragma unroll
          for (int e = 0; e < 4; ++e) { const float a0 = bflo(x1[e]), a1 = bfhi(x1[e]), b0 = bflo(x2[e]), b1 = bfhi(x2[e]);
              const float cl = e < 2 ? c0[2 * e] : c1[2 * e - 4], ch = e < 2 ? c0[2 * e + 1] : c1[2 * e - 3], sl = e < 2 ? s0[2 * e] : s1[2 * e - 4], sh = e < 2 ? s0[2 * e + 1] : s1[2 * e - 3];
              y1[e] = pk2(a0 * cl - b0 * sl, a1 * ch - b1 * sh); y2[e] = pk2(a0 * sl + b0 * cl, a1 * sh + b1 * ch); }
          qf[4] = __builtin_bit_cast(bf16x8, y1); qf[5] = __builtin_bit_cast(bf16x8, y2); } }
#pragma unroll
    for (int c = 0; c < NC; ++c)
#pragma unroll
        for (int i = 0; i < 16; ++i) o[c][i] = 0.f;
    float m_run = NEG, l_run = 0.f;
    u32x4 kr, k2r, vr0, vr1; float fr_ = 0.f;
    kr = (u32x4){0u, 0u, 0u, 0u}; k2r = kr; vr0 = kr; vr1 = kr;
#define ATT_ISSUE(t) do { const size_t key0 = (size_t)(t) * 64; \
        kr = *(const u32x4*)(s.k + (key0 + (tid >> 3)) * s.kpitch + (tid & 7) * 8); \
        if constexpr (DQK == 96) { if (tid < 256) k2r = *(const u32x4*)(s.k2 + (key0 + (tid >> 2)) * 32 + (tid & 3) * 8); } \
        if constexpr (DV == 64) { vr0 = *(const u32x4*)(s.v + (key0 + (tid >> 3)) * s.vpitch + (tid & 7) * 8); } \
        else { vr0 = *(const u32x4*)(s.v + (key0 + (tid >> 4)) * s.vpitch + (tid & 15) * 8); vr1 = *(const u32x4*)(s.v + (key0 + 32 + (tid >> 4)) * s.vpitch + (tid & 15) * 8); } \
        if constexpr (MODE == 2) { if (tid < 64) fr_ = s.f[key0 + tid]; } } while (0)
#define ATT_COMMIT(buf) do { LAS unsigned char* kb_ = lds + OFF_K + (buf) * KBUF; LAS unsigned char* vb_ = lds + OFF_V + (buf) * VBUF; \
        *(LAS u32x4*)(kb_ + (tid >> 3) * KROW + (tid & 7) * 16) = kr; \
        if constexpr (DQK == 96) { if (tid < 256) *(LAS u32x4*)(kb_ + (tid >> 2) * KROW + 128 + (tid & 3) * 16) = k2r; } \
        if constexpr (DV == 64) { *(LAS u32x4*)(vb_ + (tid >> 3) * VROW + (tid & 7) * 16) = vr0; } \
        else { *(LAS u32x4*)(vb_ + (tid >> 4) * VROW + (tid & 15) * 16) = vr0; *(LAS u32x4*)(vb_ + (32 + (tid >> 4)) * VROW + (tid & 15) * 16) = vr1; } \
        if constexpr (MODE == 2) { if (tid < 64) ((LAS float*)(lds + OFF_KB))[(buf) * 64 + tid] = (s.fref - fr_) * LOG2E; } } while (0)
    const int i16 = lane & 15, q4 = i16 >> 2, pp = i16 & 3, blk = (lane >> 4) & 1;
    const int voff = (4 * h + q4) * VROW + blk * 32 + pp * 8;
    ATT_ISSUE(TLO); ATT_COMMIT(0);
    __syncthreads();
    for (int t = TLO; t <= THI; ++t) {
        const int buf = (t - TLO) & 1;
        if (t < THI) ATT_ISSUE(t + 1);
        if (t >= tlo_w && t <= thi_w) {
            LAS unsigned char* kb = lds + OFF_K + buf * KBUF; LAS unsigned char* vb = lds + OFF_V + buf * VBUF;
            f32x16 p0, p1;
#pragma unroll
            for (int i = 0; i < 16; ++i) { p0[i] = 0.f; p1[i] = 0.f; }
#pragma unroll
            for (int d0 = 0; d0 < ND; ++d0) {
                const bf16x8 k0 = *(const LAS bf16x8*)(kb + r * KROW + d0 * 32 + h * 16);
                const bf16x8 k1 = *(const LAS bf16x8*)(kb + (32 + r) * KROW + d0 * 32 + h * 16);
                p0 = MFMA32(k0, qf[d0], p0); p1 = MFMA32(k1, qf[d0], p1);
            }
            if constexpr (MODE == 1) {
                if (t >= near_lo) {
                    const LAS float* tab = (const LAS float*)(lds + OFF_TAB);
                    const int base = (q0 + 32 * wid + r) - 64 * t + 63 - 4 * h;
#pragma unroll
                    for (int i = 0; i < 16; ++i) { const int kk = (i & 3) + 8 * (i >> 2); p0[i] += tab[base - kk]; p1[i] += tab[base - 32 - kk]; }
                } else {
#pragma unroll
                    for (int i = 0; i < 16; ++i) { p0[i] += farc; p1[i] += farc; }
                }
            }
            if constexpr (MODE == 2) {
                const LAS float* kbp = (const LAS float*)(lds + OFF_KB) + buf * 64;
#pragma unroll
                for (int g = 0; g < 4; ++g) { const f32x4 b0 = *(const LAS f32x4*)(kbp + 8 * g + 4 * h), b1 = *(const LAS f32x4*)(kbp + 32 + 8 * g + 4 * h);
#pragma unroll
                    for (int e = 0; e < 4; ++e) { p0[4 * g + e] += b0[e]; p1[4 * g + e] += b1[e]; } }
                if (t == thi_w) { const int qq = 32 * (wid & 1) + r;
#pragma unroll
                    for (int i = 0; i < 16; ++i) { const int kk = (i & 3) + 8 * (i >> 2) + 4 * h; if (kk > qq) p0[i] = NEG; if (kk + 32 > qq) p1[i] = NEG; } }
            }
            float rm = p0[0];
#pragma unroll
            for (int i = 1; i < 16; ++i) rm = fmaxf(rm, p0[i]);
#pragma unroll
            for (int i = 0; i < 16; ++i) rm = fmaxf(rm, p1[i]);
            rm = fmaxf(rm, __shfl_xor(rm, 32));
            const float mn = fmaxf(m_run, rm), alpha = __builtin_amdgcn_exp2f(m_run - mn); m_run = mn;
            float rs = 0.f;
#pragma unroll
            for (int i = 0; i < 16; ++i) { p0[i] = __builtin_amdgcn_exp2f(p0[i] - mn); p1[i] = __builtin_amdgcn_exp2f(p1[i] - mn); rs += p0[i] + p1[i]; }
            l_run = l_run * alpha + rs;
            if (__any(alpha != 1.f)) {
#pragma unroll
                for (int c = 0; c < NC; ++c)
#pragma unroll
                    for (int i = 0; i < 16; ++i) o[c][i] *= alpha;
            }
            bf16x8 pa[4];
            { u32x4 w;
              w.x = pk2(p0[0], p0[1]); w.y = pk2(p0[2], p0[3]); w.z = pk2(p0[4], p0[5]); w.w = pk2(p0[6], p0[7]); pa[0] = __builtin_bit_cast(bf16x8, w);
              w.x = pk2(p0[8], p0[9]); w.y = pk2(p0[10], p0[11]); w.z = pk2(p0[12], p0[13]); w.w = pk2(p0[14], p0[15]); pa[1] = __builtin_bit_cast(bf16x8, w);
              w.x = pk2(p1[0], p1[1]); w.y = pk2(p1[2], p1[3]); w.z = pk2(p1[4], p1[5]); w.w = pk2(p1[6], p1[7]); pa[2] = __builtin_bit_cast(bf16x8, w);
              w.x = pk2(p1[8], p1[9]); w.y = pk2(p1[10], p1[11]); w.z = pk2(p1[12], p1[13]); w.w = pk2(p1[14], p1[15]); pa[3] = __builtin_bit_cast(bf16x8, w); }
#pragma unroll
            for (int c = 0; c < NC; ++c)
#pragma unroll
                for (int ks = 0; ks < 4; ++ks) {
                    const s16x4 lo = vtr(vb + voff + ks * 16 * VROW + c * 64), hi = vtr(vb + voff + ks * 16 * VROW + 8 * VROW + c * 64);
                    const bf16x8 vf = __builtin_shufflevector(lo, hi, 0, 1, 2, 3, 4, 5, 6, 7);
                    o[c] = MFMA32(vf, pa[ks], o[c]);
                }
        }
        if (t < THI) ATT_COMMIT(buf ^ 1);
        __syncthreads();
    }
#undef ATT_ISSUE
#undef ATT_COMMIT
    l_out = l_run + __shfl_xor(l_run, 32);
}

DI int t5_bucket(int rel) {
    const int n = rel < 0 ? -rel : rel; int b;
    if (n < 8) b = n; else if (n < 12) b = 8; else if (n < 16) b = 9; else if (n < 23) b = 10; else if (n < 32) b = 11; else if (n < 46) b = 12; else if (n < 64) b = 13; else if (n < 91) b = 14; else b = 15;
    return (rel > 0 ? 16 : 0) + b;
}
template <int NC> DI void store_o(const f32x16 (&o)[NC], float inv, bf16* O, int h) {
#pragma unroll
    for (int c = 0; c < NC; ++c)
#pragma unroll
        for (int g = 0; g < 4; ++g) { u32x2 w; w.x = pk2(o[c][4 * g] * inv, o[c][4 * g + 1] * inv); w.y = pk2(o[c][4 * g + 2] * inv, o[c][4 * g + 3] * inv);
            *(u32x2*)(O + 32 * c + 8 * g + 4 * h) = w; }
}

DI void phase_ab(const Params& p, LAS unsigned char* lds, int vcu, int G) {
    const int tid = threadIdx.x, lane = tid & 63, r = lane & 31, h = lane >> 5, wid = __builtin_amdgcn_readfirstlane(tid >> 6);
    const bf16* QA = (const bf16*)(p.ws + WS_QA); const bf16* KV = (const bf16*)(p.ws + WS_KV); const bf16* KR = (const bf16*)(p.ws + WS_KROPE);
    const bf16* Y1 = (const bf16*)(p.ws + WS_Y1); bf16* MRG = (bf16*)(p.ws + WS_U);
    for (int i = 0;; ++i) {
        const int idx = i * G + vcu; if (idx >= 1024) break;
        const int slot = idx >> 8, v = idx & 255, bh = v >> 3, sx = v & 7, b = bh >> 3, hd = bh & 7;
        const int qb = slot == 0 ? sx : slot == 1 ? 15 - sx : slot == 2 ? 16 + sx : 31 - sx;
        Src s; s.rope = (const float*)(p.ws + WS_ROPE); s.q = QA + (size_t)b * SEQ * 768 + hd * 64; s.q2 = QA + (size_t)b * SEQ * 768 + 512 + hd * 32; s.qpitch = 768;
        s.k = KV + (size_t)b * SEQ * 1024 + hd * 64; s.k2 = KR + (size_t)b * SEQ * 32; s.kpitch = 1024; s.v = KV + (size_t)b * SEQ * 1024 + 512 + hd * 64; s.vpitch = 1024; s.f = nullptr; s.fref = 0.f;
        f32x16 o[2]; float l;
        core<96, 64, 0>(lds, s, qb * 256, 0, 4 * qb + 3, 0, 4 * qb + (wid >> 1), 0, 0.f, o, l);
        store_o<2>(o, 1.0f / l, MRG + (size_t)(b * SEQ + qb * 256 + 32 * wid + r) * DM + hd * 64, h);
    }
    const float lam = ((const float*)(p.ws + WS_MISC))[0];
    for (int i = 0;; ++i) {
        const int idx = i * G + vcu; if (idx >= 512) break;
        const int slot = idx >> 8, v = idx & 255, bh = v >> 4, sx = v & 15, b = bh >> 2, hb = bh & 3;
        const int qb = slot == 0 ? sx : 31 - sx;
        if (tid < 255) ((LAS float*)(lds + OFF_TAB))[tid] = p.in[6][hb * 32 + t5_bucket(63 - tid)] * LOG2E;
        const float farc = p.in[6][hb * 32 + 15] * LOG2E;
        bf16* O = MRG + (size_t)(b * SEQ + qb * 256 + 32 * wid + r) * DM + 512 + hb * 128;
#pragma unroll
        for (int comp = 0; comp < 2; ++comp) {
            Src s; s.rope = nullptr; const bf16* yb = Y1 + (size_t)b * SEQ * 2048;
            s.q = yb + 416 + hb * 128 + comp * 64; s.q2 = nullptr; s.qpitch = 2048; s.k = yb + 928 + hb * 128 + comp * 64; s.k2 = nullptr; s.kpitch = 2048;
            s.v = yb + 1440 + hb * 128; s.vpitch = 2048; s.f = nullptr; s.fref = 0.f;
            f32x16 o[4]; float l; const int cw = 4 * qb + (wid >> 1);
            core<64, 128, 1>(lds, s, qb * 256, 0, 4 * qb + 3, 0, cw, cw - 2, farc, o, l);
            const float inv = 1.0f / l;
            if (comp == 0) {
                store_o<4>(o, inv, O, h);
            } else {
                const float li = lam * inv; float ss = 0.f;
#pragma unroll
                for (int c = 0; c < 4; ++c)
#pragma unroll
                    for (int g = 0; g < 4; ++g) { const u32x2 w0 = *(const u32x2*)(O + 32 * c + 8 * g + 4 * h);
                        o[c][4 * g] = bflo(w0.x) - li * o[c][4 * g]; o[c][4 * g + 1] = bfhi(w0.x) - li * o[c][4 * g + 1];
                        o[c][4 * g + 2] = bflo(w0.y) - li * o[c][4 * g + 2]; o[c][4 * g + 3] = bfhi(w0.y) - li * o[c][4 * g + 3];
                        ss += (o[c][4 * g] * o[c][4 * g] + o[c][4 * g + 1] * o[c][4 * g + 1]) + (o[c][4 * g + 2] * o[c][4 * g + 2] + o[c][4 * g + 3] * o[c][4 * g + 3]); }
                ss += __shfl_xor(ss, 32);
                const float rstd = 0.8f / sqrtf(ss * (1.f / 128.f) + 1e-6f);
#pragma unroll
                for (int c = 0; c < 4; ++c)
#pragma unroll
                    for (int g = 0; g < 4; ++g) { const f32x4 sg = *(const f32x4*)(p.in[16] + 32 * c + 8 * g + 4 * h);
                        u32x2 w; w.x = pk2(o[c][4 * g] * rstd * sg[0], o[c][4 * g + 1] * rstd * sg[1]); w.y = pk2(o[c][4 * g + 2] * rstd * sg[2], o[c][4 * g + 3] * rstd * sg[3]);
                        *(u32x2*)(O + 32 * c + 8 * g + 4 * h) = w; }
            }
        }
    }
}

DI void phase_cd(const Params& p, LAS unsigned char* lds, int vcu, int G) {
    const int tid = threadIdx.x, lane = tid & 63, r = lane & 31, h = lane >> 5, wid = __builtin_amdgcn_readfirstlane(tid >> 6);
    const bf16* QKV = (const bf16*)(p.ws + WS_QKV1); bf16* MRG = (bf16*)(p.ws + WS_MRG1); const float* F = (const float*)(p.ws + WS_F);
    for (int i = 0;; ++i) {
        const int idx = i * G + vcu; if (idx >= 1024) break;
        const int slot = idx >> 8, v = idx & 255, bh = v >> 3, sx = v & 7, b = bh >> 3, hd = bh & 7;
        const int qb = slot == 0 ? sx : slot == 1 ? 15 - sx : slot == 2 ? 16 + sx : 31 - sx;
        const bf16* yb = QKV + (size_t)b * SEQ * 3072;
        Src s; s.rope = nullptr; s.q = yb + hd * 64; s.q2 = nullptr; s.qpitch = 3072; s.k = yb + 512 + hd * 64; s.k2 = nullptr; s.kpitch = 3072; s.v = yb + 1024 + hd * 64; s.vpitch = 3072;
        s.f = F + (size_t)bh * SEQ; s.fref = s.f[qb * 256];
        f32x16 o[2]; float l;
        core<64, 64, 2>(lds, s, qb * 256, 0, 4 * qb + 3, 0, 4 * qb + (wid >> 1), 0, 0.f, o, l);
        store_o<2>(o, 1.0f / l, MRG + (size_t)(b * SEQ + qb * 256 + 32 * wid + r) * DM + hd * 64, h);
    }
    for (int i = 0;; ++i) {
        const int idx = i * G + vcu; if (idx >= 1024) break;
        const int slot = idx >> 8, v = idx & 255, bh = v >> 3, sx = v & 7, b = bh >> 3, hd = bh & 7;
        const int qb = 4 * sx + slot;
        const float* rt = p.in[20] + hd * 257;
        if (tid < 255) { int d = tid - 63; d = d < -128 ? -128 : (d > 128 ? 128 : d); ((LAS float*)(lds + OFF_TAB))[tid] = rt[d + 128] * LOG2E; }
        const float farc = rt[256] * LOG2E;
        const bf16* yb = QKV + (size_t)b * SEQ * 3072;
        Src s; s.rope = nullptr; s.q = yb + 1536 + hd * 64; s.q2 = nullptr; s.qpitch = 3072; s.k = yb + 2048 + hd * 64; s.k2 = nullptr; s.kpitch = 3072; s.v = yb + 2560 + hd * 64; s.vpitch = 3072; s.f = nullptr; s.fref = 0.f;
        f32x16 o[2]; float l; const int cw = 4 * qb + (wid >> 1);
        const int TLO = (4 * qb - 8) > 0 ? (4 * qb - 8) : 0, tlo_w = (cw - 8) > 0 ? (cw - 8) : 0;
        core<64, 64, 1>(lds, s, qb * 256, TLO, 4 * qb + 3, tlo_w, cw, cw - 2, farc, o, l);
        store_o<2>(o, 1.0f / l, MRG + (size_t)(b * SEQ + qb * 256 + 32 * wid + r) * DM + 512 + hd * 64, h);
    }
}
}

constexpr int NPHASE = 20;
__global__ void __launch_bounds__(NTHR, 2) mega_fwd(Params p) {
    extern __shared__ __attribute__((aligned(16))) unsigned char lds_raw[];
    LAS unsigned char* lds = (LAS unsigned char*)lds_raw;
    cg::grid_group grid = cg::this_grid();
    const int G = gridDim.x, bx = blockIdx.x;
    const int vcu = (G % 8 == 0) ? (bx % 8) * (G / 8) + bx / 8 : bx;
    unsigned char* ws = p.ws;
    const float* MOD = (const float*)(ws + WS_MOD);
    typedef pg8::EpiBf16<0> EpiSt;
#define IN(k) (p.lo <= (k) && (k) < p.hi)
#define SEAM(k) do { if (IN(k) && IN((k) + 1)) grid.sync(); } while (0)
#define STORE_GEMM(Aoff, Woff, N_, K_, Ooff, ldc_, splitc, splits) do { \
        pg8::Gemm g{(const pg8::bf16_t*)(ws + (Aoff)), (const pg8::bf16_t*)(ws + (Woff)), MROWS, (N_), (K_)}; \
        EpiSt E{(pg8::bf16_t*)(ws + (Ooff)), (ldc_), nullptr, (splitc), (splits), 1.f}; \
        pg8::StaticOrder S; S.init(MROWS, (N_), G, bx); \
        pg8::gemm_phase<EpiSt, pg8::StaticOrder, true, true>(lds, g, S, E); } while (0)
#define RESID_GEMM(Aoff, Woff, K_, xin_, sub) do { \
        pg8::Gemm g{(const pg8::bf16_t*)(ws + (Aoff)), (const pg8::bf16_t*)(ws + (Woff)), MROWS, 1024, (K_)}; \
        EpiResid E{(xin_), p.out, MOD + (sub) * 4 * 3072 + 2048}; \
        pg8::StaticOrder S; S.init(MROWS, 1024, G, bx); \
        pg8::gemm_phase<EpiResid, pg8::StaticOrder, true, true>(lds, g, S, E); } while (0)
    if (IN(0)) p_prologue(p, lds);
    SEAM(0);
    if (IN(1)) p_modulate(p);
    SEAM(1);
    if (IN(2)) STORE_GEMM(WS_U, W_ABIN, 2048, 1024, WS_Y1, 2048, 0, 0);
    SEAM(2);
    if (IN(3)) p_norm3(p);
    SEAM(3);
    if (IN(4)) {
        STORE_GEMM(WS_CQN, W_UQ, 768, 256, WS_QA, 768, 0, 0);
        STORE_GEMM(WS_CKVN, W_UKV, 1024, 128, WS_KV, 1024, 0, 0);
    }
    SEAM(4);
    if (IN(5)) att::phase_ab(p, lds, vcu, G);
    SEAM(5);
    if (IN(6)) RESID_GEMM(WS_U, W_ABOUT, 1024, p.in[0], 0);
    SEAM(6);
    if (IN(7)) p_ln(p, 0, 1, false);
    SEAM(7);
    if (IN(8)) STORE_GEMM(WS_U, W_UP0, 2 * DFF, 1024, WS_G, DFF, DFF, (size_t)(WS_H - WS_G) / 2);
    SEAM(8);
    if (IN(9)) p_conv(p, 0);
    SEAM(9);
    if (IN(10)) RESID_GEMM(WS_H, W_DN0, DFF, p.out, 1);
    SEAM(10);
    if (IN(11)) p_ln(p, 1, 2, true);
    SEAM(11);
    if (IN(12)) { p_scan(p, lds); STORE_GEMM(WS_U, W_CDIN, 3072, 1024, WS_QKV1, 3072, 0, 0); }
    SEAM(12);
    if (IN(13)) att::phase_cd(p, lds, vcu, G);
    SEAM(13);
    if (IN(14)) RESID_GEMM(WS_MRG1, W_CDOUT, 1024, p.out, 2);
    SEAM(14);
    if (IN(15)) p_ln(p, 2, 3, false);
    SEAM(15);
    if (IN(16)) STORE_GEMM(WS_U, W_UP1, 2 * DFF, 1024, WS_G, DFF, DFF, (size_t)(WS_H - WS_G) / 2);
    SEAM(16);
    if (IN(17)) p_conv(p, 1);
    SEAM(17);
    if (IN(18)) RESID_GEMM(WS_H, W_DN1, DFF, p.out, 3);
    SEAM(18);
    if (IN(19)) p_ln(p, 3, -1, false);
}

extern "C" void kernel_launch(void* const* d_in, const int* in_sizes, int n_in, void* d_out, int out_size, void* d_ws, size_t ws_size, hipStream_t stream) {
    static int grid = 0;
    if (grid == 0) {
        if (n_in != 27 || out_size != MROWS * DM || ws_size < WS_END) { fprintf(stderr, "kernel_launch: unexpected shapes (n_in %d out %d ws %zu)\n", n_in, out_size, ws_size); grid = -1; return; }
        int dev = 0, cus = 0, per_cu = 0;
        hipGetDevice(&dev); hipDeviceGetAttribute(&cus, hipDeviceAttributeMultiprocessorCount, dev);
        if (hipFuncSetAttribute((const void*)mega_fwd, hipFuncAttributeMaxDynamicSharedMemorySize, LDS_BYTES) != hipSuccess) { fprintf(stderr, "kernel_launch: hipFuncSetAttribute failed\n"); grid = -1; return; }
        if (hipOccupancyMaxActiveBlocksPerMultiprocessor(&per_cu, (const void*)mega_fwd, NTHR, LDS_BYTES) != hipSuccess || per_cu < 1) { fprintf(stderr, "kernel_launch: occupancy query says %d\n", per_cu); per_cu = 1; }
        (void)hipGetLastError();
        grid = cus;
    }
    if (grid < 0) return;
    Params a{};
    for (int i = 0; i < 27; ++i) a.in[i] = (const float*)d_in[i];
    a.out = (float*)d_out; a.ws = (unsigned char*)d_ws; a.lo = 0; a.hi = NPHASE;
    void* args[] = {&a};
    hipError_t e = hipLaunchCooperativeKernel((const void*)mega_fwd, dim3(grid), dim3(NTHR), args, LDS_BYTES, stream);
    if (e != hipSuccess) fprintf(stderr, "cooperative launch failed: %s (grid %d)\n", hipGetErrorString(e), grid);
}
```

```cpp
#include <hip/hip_runtime.h>
#include <hip/hip_cooperative_groups.h>
#include <cstdio>
#include <cstdint>
namespace cg = cooperative_groups;
namespace pg8 {
#define PG8_LAS __attribute__((address_space(3)))
typedef unsigned short bf16_t;
typedef short bf16x8 __attribute__((ext_vector_type(8)));
typedef float f32x4 __attribute__((ext_vector_type(4)));
typedef unsigned u32x4 __attribute__((ext_vector_type(4)));
constexpr int BM = 256, BK = 64, HALF = 128, HTB = HALF * BK * 2  , STAGE_BYTES = 8 * HTB, NXCD = 8, WGM = 8;

__host__ __device__ __forceinline__ int lds_byte(int r, int c) { const int st = (r >> 4) * 2 + (c >> 5), rr = r & 15, cc = c & 31, ob = rr * 64 + cc * 2; return st * 1024 + (ob ^ (((ob >> 9) & 1) << 5)); }
__host__ __device__ __forceinline__ void stage_rc(int b, int& R, int& C) { const int st = b / 1024, sb = b % 1024, swz = sb ^ (((sb >> 9) & 1) << 5); R = (st >> 1) * 16 + swz / 64; C = (st & 1) * 32 + (swz % 64) / 2; }
__host__ __device__ __forceinline__ int perm32(int rho) { const int n = rho >> 4, i = rho & 15; return 8 * (i >> 2) + 4 * n + (i & 3); }

struct Unit { int pm, pn; };
struct Gemm { const bf16_t* A; const bf16_t* Bt; int M, N, K; };

struct StaticOrder {
    int nM, nN, nwg, G, c;
    __host__ __device__ void init(int M, int N, int G_, int c_) { nM = M / BM; nN = N / BM; nwg = nM * nN; G = G_; c = c_; }
    __host__ __device__ bool next(int i, Unit& u) const {
        const long L = (long)i * G + c; if (L >= nwg) return false;
        int wgid = (int)L; { const int q = nwg / NXCD, r = nwg % NXCD, xcd = wgid % NXCD, off = wgid / NXCD; wgid = (xcd < r ? xcd * (q + 1) : r * (q + 1) + (xcd - r) * q) + off; }
        const int nig = WGM * nN, gid = wgid / nig, fm = gid * WGM, gsz = (nM - fm) < WGM ? (nM - fm) : WGM;
        u.pm = fm + ((wgid % nig) % gsz); u.pn = (wgid % nig) / gsz; return true;
    }
    __device__ __forceinline__ void a_ready(const Unit&) const {}
    __device__ __forceinline__ void done(const Unit&) const {}
};

__device__ __forceinline__ unsigned cvt_pk_bf16(float lo, float hi) { unsigned r; asm volatile("v_cvt_pk_bf16_f32 %0, %1, %2" : "=v"(r) : "v"(lo), "v"(hi)); return r; }
typedef float f32x2 __attribute__((ext_vector_type(2)));
__device__ __forceinline__ f32x2 gelu_pk(f32x2 v) {
    const f32x2 av = __builtin_elementwise_abs(v), d = av * 0.2316418882f + 1.0f;
    f32x2 t; t.x = __builtin_amdgcn_rcpf(d.x); t.y = __builtin_amdgcn_rcpf(d.y);
    f32x2 q = t * 0.5307027145f + (-0.7265760135f); q = q * t + 0.7107068705f; q = q * t + (-0.142248368f); q = q * t + 0.127414796f; q = q * t;
    const f32x2 s = (v * v) * (-0.72134752044f);
    f32x2 e; e.x = __builtin_amdgcn_exp2f(s.x); e.y = __builtin_amdgcn_exp2f(s.y);
    const f32x2 m = v * (q * e), r = v - m;
    f32x2 o; o.x = v.x < 0.f ? m.x : r.x; o.y = v.y < 0.f ? m.y : r.y; return o;
}

template <int ACT  > struct EpiBf16 {
    static constexpr bool PERM = true, AFTER_DRAIN = false; static_assert(ACT == 0 || ACT == 1, "EpiBf16: ACT is 0 (none) or 1 (gelu_pk)");
    bf16_t* O; int ldc; const float* bias; int split_cols; size_t split_stride; float scale0;
    __device__ __forceinline__ void operator()(const f32x4 (&acc)[2][2][4][2], const Unit& u, int wr, int wc, int fr, int fq) const {
        const int row0 = u.pm * BM + wr * 64 + fr; int colt = u.pn * BM; bf16_t* base = O;
        float sc = 1.f; if (split_cols) { const int t = colt / split_cols; base += (size_t)t * split_stride; colt -= t * split_cols; if (t == 0) sc = scale0; }
        const int col0 = colt + wc * 32 + 8 * fq, bcol0 = u.pn * BM + wc * 32 + 8 * fq;
        f32x4 bv[2][2];
#pragma unroll
        for (int bj = 0; bj < 2; ++bj)
#pragma unroll
            for (int n = 0; n < 2; ++n) bv[bj][n] = bias ? *(const f32x4*)(bias + bcol0 + bj * HALF + 4 * n) : (f32x4){0.f, 0.f, 0.f, 0.f};
#pragma unroll
        for (int ai = 0; ai < 2; ++ai)
#pragma unroll
            for (int m = 0; m < 4; ++m) { bf16_t* rowp = base + (size_t)(row0 + ai * HALF + m * 16) * ldc + col0;
#pragma unroll
                for (int bj = 0; bj < 2; ++bj) { f32x4 v0 = acc[ai][bj][m][0] + bv[bj][0], v1 = acc[ai][bj][m][1] + bv[bj][1];
                    if (ACT == 1) { f32x2 a = gelu_pk((f32x2){v0[0], v0[1]}), b = gelu_pk((f32x2){v0[2], v0[3]}), c = gelu_pk((f32x2){v1[0], v1[1]}), d = gelu_pk((f32x2){v1[2], v1[3]});
                        v0 = (f32x4){a.x, a.y, b.x, b.y}; v1 = (f32x4){c.x, c.y, d.x, d.y}; }
                    v0 = v0 * sc; v1 = v1 * sc; u32x4 w; w.x = cvt_pk_bf16(v0[0], v0[1]); w.y = cvt_pk_bf16(v0[2], v0[3]); w.z = cvt_pk_bf16(v1[0], v1[1]); w.w = cvt_pk_bf16(v1[2], v1[3]);
                    *(u32x4*)(rowp + bj * HALF) = w; } }
    }
};

struct PanelStats {
    unsigned* xbuf;
    unsigned* cnt;
    unsigned* tmo;
    int ntn; float eps;
    unsigned code;
    __device__ __forceinline__ bool run(const f32x4 (&v)[2][2][4][2], const Unit& u, int wr, int wc, int fr, int fq, PG8_LAS unsigned char* lds, int wid, int lane) const {
        typedef float f32x2v __attribute__((ext_vector_type(2)));
        PG8_LAS f32x2v* P = (PG8_LAS f32x2v*)lds;
        PG8_LAS f32x2v* S = (PG8_LAS f32x2v*)(lds + 8192);
        PG8_LAS unsigned* flag = (PG8_LAS unsigned*)(lds + 8192 + 2048);
#pragma unroll
        for (int ai = 0; ai < 2; ++ai)
#pragma unroll
            for (int m = 0; m < 4; ++m) {
                float s = 0.f;
#pragma unroll
                for (int bj = 0; bj < 2; ++bj)
#pragma unroll
                    for (int n = 0; n < 2; ++n) { const f32x4 x = v[ai][bj][m][n]; s += (x[0] + x[1]) + (x[2] + x[3]); }
                s += __shfl_xor(s, 16); s += __shfl_xor(s, 32);
                const float mw = s * (1.0f / 64.0f); float q = 0.f;
#pragma unroll
                for (int bj = 0; bj < 2; ++bj)
#pragma unroll
                    for (int n = 0; n < 2; ++n) { const f32x4 d = v[ai][bj][m][n] - mw; q += (d[0] * d[0] + d[1] * d[1]) + (d[2] * d[2] + d[3] * d[3]); }
                q += __shfl_xor(q, 16); q += __shfl_xor(q, 32);
                if (fq == 0) P[(ai * HALF + wr * 64 + m * 16 + fr) * 4 + wc] = (f32x2v){mw, q};
            }
        asm volatile("s_waitcnt lgkmcnt(0)" ::: "memory"); __builtin_amdgcn_s_barrier(); asm volatile("" ::: "memory");
#if defined(BROKEN_EXCHANGE_NO_WAIT)
#warning BROKEN CONTROL BUILD: the row-statistics exchange does not wait; results are wrong by design
        if (blockIdx.x >= 64) { const long long t0_ = clock64(); while (clock64() - t0_ < 60000) __builtin_amdgcn_s_sleep(8); }
#endif
        const int row = wid * 32 + (lane & 31);
        if (lane < 32) {
            const f32x2v a = P[row * 4 + 0], b = P[row * 4 + 1], c = P[row * 4 + 2], d = P[row * 4 + 3];
            const float mt = (a.x + b.x + c.x + d.x) * 0.25f;
            const float da = a.x - mt, db = b.x - mt, dc = c.x - mt, dd = d.x - mt;
            const float m2 = (a.y + b.y) + (c.y + d.y) + 64.0f * ((da * da + db * db) + (dc * dc + dd * dd));
            unsigned long long* slot = (unsigned long long*)xbuf + ((size_t)(u.pm * BM + row) * 4 + u.pn);
            __hip_atomic_store(slot, ((unsigned long long)__float_as_uint(m2) << 32) | __float_as_uint(mt), __ATOMIC_RELAXED, __HIP_MEMORY_SCOPE_AGENT);
        }
        asm volatile("s_waitcnt vmcnt(0)" ::: "memory");
        if (lane == 0) __hip_atomic_fetch_add(cnt + 64 * u.pm, 1u, __ATOMIC_RELAXED, __HIP_MEMORY_SCOPE_AGENT);
        if (wid == 0) {
            bool dead = false; const unsigned long long t0 = __builtin_amdgcn_s_memrealtime(); const unsigned want = 8u * (unsigned)ntn;
            for (;;) {
#if defined(BROKEN_EXCHANGE_NO_WAIT)
                break;
#endif
                if ((unsigned)__builtin_amdgcn_readfirstlane(__hip_atomic_load(cnt + 64 * u.pm, __ATOMIC_RELAXED, __HIP_MEMORY_SCOPE_AGENT)) >= want) break;
                if (__builtin_amdgcn_s_memrealtime() - t0 > 2000000ull) {
                    if (lane == 0) { unsigned expect = 0u; __hip_atomic_compare_exchange_strong(tmo + 1, &expect, code | (unsigned)(u.pm & 0xff), __ATOMIC_RELAXED, __ATOMIC_RELAXED, __HIP_MEMORY_SCOPE_AGENT);
                                     __hip_atomic_store(tmo, 1u, __ATOMIC_RELAXED, __HIP_MEMORY_SCOPE_AGENT); }
                    dead = true; break; }
                __builtin_amdgcn_s_sleep(2);
            }
            __builtin_amdgcn_fence(__ATOMIC_ACQUIRE, "agent");
            if (lane == 0) flag[0] = dead ? 1u : 0u;
        }
        asm volatile("s_waitcnt vmcnt(0) lgkmcnt(0)" ::: "memory"); __builtin_amdgcn_s_barrier(); asm volatile("" ::: "memory");
        const bool bad = flag[0] != 0u;
        if (lane < 32) {
            const unsigned long long* slot = (const unsigned long long*)xbuf + (size_t)(u.pm * BM + row) * 4; float mt[4], m2[4]; float ms = 0.f;
#pragma unroll
            for (int t = 0; t < 4; ++t) { if (t < ntn) { const unsigned long long w = __hip_atomic_load(slot + t, __ATOMIC_RELAXED, __HIP_MEMORY_SCOPE_AGENT); mt[t] = __uint_as_float((unsigned)w); m2[t] = __uint_as_float((unsigned)(w >> 32)); } else { mt[t] = 0.f; m2[t] = 0.f; } ms += mt[t]; }
            const float mean = ms / (float)ntn; float q = 0.f;
#pragma unroll
            for (int t = 0; t < 4; ++t) if (t < ntn) { const float dm = mt[t] - mean; q += m2[t] + 256.0f * dm * dm; }
            S[row] = (f32x2v){mean, 1.0f / sqrtf(q / (256.0f * (float)ntn) + eps)};
        }
        asm volatile("s_waitcnt lgkmcnt(0)" ::: "memory"); __builtin_amdgcn_s_barrier(); asm volatile("" ::: "memory");
        return bad;
    }
};
struct EpiLnRes {
    static constexpr bool PERM = false, AFTER_DRAIN = true;
    const float* base; float* out; int ldc; const float* bias; PanelStats st; unsigned poison;
    __device__ __forceinline__ void fused(f32x4 (&acc)[2][2][4][2], const Unit& u, int wr, int wc, int fr, int fq, PG8_LAS unsigned char* lds, int wid, int lane) const {
        typedef float f32x2v __attribute__((ext_vector_type(2)));
        const PG8_LAS f32x2v* S = (const PG8_LAS f32x2v*)(lds + 8192);
        const int col0 = u.pn * BM + wc * 32 + 4 * fq;
#pragma unroll
        for (int bj = 0; bj < 2; ++bj)
#pragma unroll
            for (int n = 0; n < 2; ++n) { const f32x4 bv = bias ? *(const f32x4*)(bias + col0 + bj * HALF + n * 16) : (f32x4){0.f, 0.f, 0.f, 0.f};
#pragma unroll
                for (int ai = 0; ai < 2; ++ai)
#pragma unroll
                    for (int m = 0; m < 4; ++m) acc[ai][bj][m][n] += bv; }
        f32x4 pre[4][2][2];
#pragma unroll
        for (int m = 0; m < 4; ++m) { const size_t off = (size_t)(u.pm * BM + wr * 64 + m * 16 + fr) * ldc + col0;
#pragma unroll
            for (int bj = 0; bj < 2; ++bj)
#pragma unroll
                for (int n = 0; n < 2; ++n) pre[m][bj][n] = *(const f32x4*)(base + off + bj * HALF + n * 16); }
        const bool bad = st.run(acc, u, wr, wc, fr, fq, lds, wid, lane) || poison != 0u;
        const float qnan = __builtin_nanf("");
#pragma unroll
        for (int ai = 0; ai < 2; ++ai)
#pragma unroll
            for (int m = 0; m < 4; ++m) { const int r = ai * HALF + wr * 64 + m * 16 + fr; const f32x2v sr = S[r]; const size_t off = (size_t)(u.pm * BM + r) * ldc + col0;
#pragma unroll
                for (int bj = 0; bj < 2; ++bj)
#pragma unroll
                    for (int n = 0; n < 2; ++n) { const f32x4 bs = ai == 0 ? pre[m][bj][n] : *(const f32x4*)(base + off + bj * HALF + n * 16); f32x4 o = bs + (acc[ai][bj][m][n] - sr.x) * sr.y;
                        if (bad) o = (f32x4){qnan, qnan, qnan, qnan}; *(f32x4*)(out + off + bj * HALF + n * 16) = o; }
                if (m & 1) asm volatile("" ::: "memory"); }
    }
};
struct EpiLnResLn {
    static constexpr bool PERM = false, AFTER_DRAIN = true;
    const float* base; float* out; bf16_t* xn; int ldc; const float* bias; PanelStats st1, st2; unsigned poison;
    __device__ __forceinline__ void fused(f32x4 (&acc)[2][2][4][2], const Unit& u, int wr, int wc, int fr, int fq, PG8_LAS unsigned char* lds, int wid, int lane) const {
        typedef float f32x2v __attribute__((ext_vector_type(2))); typedef unsigned u32x2v __attribute__((ext_vector_type(2)));
        const PG8_LAS f32x2v* S = (const PG8_LAS f32x2v*)(lds + 8192);
        const int col0 = u.pn * BM + wc * 32 + 4 * fq;
#pragma unroll
        for (int bj = 0; bj < 2; ++bj)
#pragma unroll
            for (int n = 0; n < 2; ++n) { const f32x4 bv = bias ? *(const f32x4*)(bias + col0 + bj * HALF + n * 16) : (f32x4){0.f, 0.f, 0.f, 0.f};
#pragma unroll
                for (int ai = 0; ai < 2; ++ai)
#pragma unroll
                    for (int m = 0; m < 4; ++m) acc[ai][bj][m][n] += bv; }
        bool bad = st1.run(acc, u, wr, wc, fr, fq, lds, wid, lane) || poison != 0u;
        const float qnan = __builtin_nanf("");
#pragma unroll
        for (int ai = 0; ai < 2; ++ai)
#pragma unroll
            for (int m = 0; m < 4; ++m) { const int r = ai * HALF + wr * 64 + m * 16 + fr; const f32x2v sr = S[r]; const size_t off = (size_t)(u.pm * BM + r) * ldc + col0;
#pragma unroll
                for (int bj = 0; bj < 2; ++bj)
#pragma unroll
                    for (int n = 0; n < 2; ++n) { const f32x4 bs = *(const f32x4*)(base + off + bj * HALF + n * 16); acc[ai][bj][m][n] = bs + (acc[ai][bj][m][n] - sr.x) * sr.y; }
                asm volatile("" : "+v"(acc[ai][0][m][0]), "+v"(acc[ai][0][m][1]), "+v"(acc[ai][1][m][0]), "+v"(acc[ai][1][m][1]));
                if (m & 1) asm volatile("" ::: "memory"); }
        const bool bad1 = bad;
        bad = st2.run(acc, u, wr, wc, fr, fq, lds, wid, lane) || bad;
#pragma unroll
        for (int ai = 0; ai < 2; ++ai)
#pragma unroll
            for (int m = 0; m < 4; ++m) { const int r = ai * HALF + wr * 64 + m * 16 + fr; const f32x2v sr = S[r]; const size_t off = (size_t)(u.pm * BM + r) * ldc + col0;
#pragma unroll
                for (int bj = 0; bj < 2; ++bj)
#pragma unroll
                    for (int n = 0; n < 2; ++n) { const f32x4 x1 = acc[ai][bj][m][n]; *(f32x4*)(out + off + bj * HALF + n * 16) = bad1 ? (f32x4){qnan, qnan, qnan, qnan} : x1;
                        const f32x4 o = (x1 - sr.x) * sr.y; u32x2v w; w.x = cvt_pk_bf16(o[0], o[1]); w.y = cvt_pk_bf16(o[2], o[3]);
                        if (bad) { w.x = 0x7fc07fc0u; w.y = 0x7fc07fc0u; } *(u32x2v*)(xn + off + bj * HALF + n * 16) = w; }
                asm volatile("" ::: "memory"); }
    }
};

template <class Epi, class Sched, bool ALIGN_EPI = false, bool SP2 = false>
__device__ __forceinline__ void gemm_phase(PG8_LAS unsigned char* lds, const Gemm g, const Sched& S, const Epi& E) {
    const int tid = threadIdx.x, wid = __builtin_amdgcn_readfirstlane(tid >> 6), lane = tid & 63, wr = wid >> 2, wc = wid & 3, fr = lane & 15, fq = lane >> 4;
    const int K = g.K, nt = K / BK;
    unsigned voffA[2], voffB[2];
#pragma unroll
    for (int i = 0; i < 2; ++i) { int R, C; stage_rc(tid * 16 + i * 8192, R, C); const int Rb = Epi::PERM ? ((R & ~31) + perm32(R & 31)) : R;
        voffA[i] = (unsigned)(R * K + C) * 2u; voffB[i] = (unsigned)(Rb * K + C) * 2u; }
    const size_t kstep = (size_t)(BK * 2);
    const size_t hstep = (size_t)HALF * K * 2;
    const size_t tstep = 2 * hstep;
    const unsigned ldsw = (unsigned)wid * 1024u;
    const int aoff = lds_byte(wr * 64 + fr, fq * 8), boff = lds_byte(wc * 32 + fr, fq * 8);
#define PG8_SA(b, h) (((b) * 2 + (h)) * HTB)
#define PG8_SB(b, h) ((4 + (b) * 2 + (h)) * HTB)
#define PG8_STAGE(bufoff, gbase, voff) do { _Pragma("unroll") for (int _i = 0; _i < 2; ++_i) \
        __builtin_amdgcn_global_load_lds((const unsigned*)((const char*)(gbase) + (voff)[_i]), (PG8_LAS unsigned*)(lds + (bufoff) + ldsw + _i * 8192), 16, 0, 0); } while (0)
#define PG8_LDA(dst, b, h) do { _Pragma("unroll") for (int m = 0; m < 4; ++m) _Pragma("unroll") for (int k = 0; k < 2; ++k) dst[m][k] = *(const PG8_LAS bf16x8*)(lds + PG8_SA(b, h) + aoff + m * 2048 + k * 1024); } while (0)
#define PG8_LDB(dst, b, h) do { _Pragma("unroll") for (int n = 0; n < 2; ++n) _Pragma("unroll") for (int k = 0; k < 2; ++k) dst[n][k] = *(const PG8_LAS bf16x8*)(lds + PG8_SB(b, h) + boff + n * 2048 + k * 1024); } while (0)
#define PG8_MMA(ai, bj, At, Bt) do { __builtin_amdgcn_s_setprio(1); _Pragma("unroll") for (int m = 0; m < 4; ++m) _Pragma("unroll") for (int n = 0; n < 2; ++n) _Pragma("unroll") for (int k = 0; k < 2; ++k) \
        acc[ai][bj][m][n] = __builtin_amdgcn_mfma_f32_16x16x32_bf16(Bt[n][k], At[m][k], acc[ai][bj][m][n], 0, 0, 0); __builtin_amdgcn_s_setprio(0); } while (0)
#define PG8_WAIT_V(n) asm volatile("s_waitcnt vmcnt(" #n ")" ::: "memory")
#define PG8_WAIT_L(n) asm volatile("s_waitcnt lgkmcnt(" #n ")" ::: "memory")
#define PG8_BAR __builtin_amdgcn_s_barrier()
#define PG8_SCHED __builtin_amdgcn_sched_barrier(0)
    Unit cur, nxt; int ui = 0;
    if (!S.next(0, cur)) return;
    f32x4 acc[2][2][4][2];
#pragma unroll
    for (int a = 0; a < 2; ++a)
#pragma unroll
        for (int b = 0; b < 2; ++b)
#pragma unroll
            for (int m = 0; m < 4; ++m)
#pragma unroll
                for (int n = 0; n < 2; ++n) acc[a][b][m][n] = (f32x4){0.f, 0.f, 0.f, 0.f};
    bf16x8 At[4][2], B0[2][2], B1[2][2];
    const char* cA = (const char*)g.A + (size_t)cur.pm * tstep; const char* cB = (const char*)g.Bt + (size_t)cur.pn * tstep;
    S.a_ready(cur);
    if constexpr (SP2) {
        PG8_STAGE(PG8_SB(0, 0), cB, voffB); PG8_STAGE(PG8_SB(0, 1), cB + hstep, voffB); PG8_STAGE(PG8_SA(0, 0), cA, voffA); PG8_STAGE(PG8_SA(0, 1), cA + hstep, voffA);
        if (wr == 1) PG8_BAR;
        PG8_WAIT_V(2); PG8_BAR;
        PG8_STAGE(PG8_SB(1, 0), cB + kstep, voffB); PG8_STAGE(PG8_SA(1, 0), cA + kstep, voffA); PG8_STAGE(PG8_SB(1, 1), cB + hstep + kstep, voffB);
        PG8_WAIT_V(6); PG8_BAR;
    } else {
        PG8_STAGE(PG8_SB(0, 0), cB, voffB); PG8_STAGE(PG8_SA(0, 0), cA, voffA); PG8_STAGE(PG8_SB(0, 1), cB + hstep, voffB); PG8_STAGE(PG8_SA(0, 1), cA + hstep, voffA);
        if (wr == 1) PG8_BAR;
        PG8_WAIT_V(4); PG8_BAR;
        PG8_STAGE(PG8_SB(1, 0), cB + kstep, voffB); PG8_STAGE(PG8_SA(1, 0), cA + kstep, voffA); PG8_STAGE(PG8_SB(1, 1), cB + hstep + kstep, voffB);
        PG8_WAIT_V(6); PG8_BAR;
    }
    for (;;) {
        const bool has_next = S.next(ui + 1, nxt);
        const char* nA = has_next ? (const char*)g.A + (size_t)nxt.pm * tstep : cA; const char* nB = has_next ? (const char*)g.Bt + (size_t)nxt.pn * tstep : cB;
        for (int t = 0; t < nt; t += 2) {
            const bool last = (t == nt - 2);
            const char* a1 = cA + (size_t)(t + 1) * kstep;
            const char* a2 = last ? nA : cA + (size_t)(t + 2) * kstep; const char* b2 = last ? nB : cB + (size_t)(t + 2) * kstep;
            const char* a3 = a2 + kstep; const char* b3 = b2 + kstep;
            if (last && has_next) S.a_ready(nxt);
            if constexpr (SP2) {
            PG8_LDB(B0, 0, 0); PG8_LDB(B1, 0, 1); PG8_SCHED; PG8_LDA(At, 0, 0); PG8_STAGE(PG8_SA(1, 1), a1 + hstep, voffA);
            PG8_WAIT_V(8); PG8_WAIT_L(0); PG8_BAR; PG8_MMA(0, 0, At, B0); PG8_MMA(0, 1, At, B1); PG8_BAR; PG8_SCHED;
            PG8_LDA(At, 0, 1); PG8_STAGE(PG8_SB(0, 0), b2, voffB); PG8_STAGE(PG8_SB(0, 1), b2 + hstep, voffB); PG8_STAGE(PG8_SA(0, 0), a2, voffA);
            PG8_WAIT_V(8); PG8_WAIT_L(0); PG8_BAR; PG8_MMA(1, 0, At, B0); PG8_MMA(1, 1, At, B1); PG8_BAR; PG8_SCHED;
            PG8_LDB(B0, 1, 0); PG8_LDB(B1, 1, 1); PG8_SCHED; PG8_LDA(At, 1, 0); PG8_STAGE(PG8_SA(0, 1), a2 + hstep, voffA);
            PG8_WAIT_V(8); PG8_WAIT_L(0); PG8_BAR; PG8_MMA(0, 0, At, B0); PG8_MMA(0, 1, At, B1); PG8_BAR; PG8_SCHED;
            PG8_LDA(At, 1, 1); PG8_STAGE(PG8_SB(1, 0), b3, voffB); PG8_STAGE(PG8_SB(1, 1), b3 + hstep, voffB); PG8_STAGE(PG8_SA(1, 0), a3, voffA);
            PG8_WAIT_V(8); PG8_WAIT_L(0); PG8_BAR; PG8_MMA(1, 0, At, B0); PG8_MMA(1, 1, At, B1); PG8_BAR; PG8_SCHED;
            } else {
            PG8_LDB(B0, 0, 0); PG8_SCHED; PG8_LDA(At, 0, 0); PG8_STAGE(PG8_SA(1, 1), a1 + hstep, voffA);
            PG8_WAIT_L(8); PG8_BAR; PG8_WAIT_L(0); PG8_MMA(0, 0, At, B0); PG8_BAR; PG8_SCHED;
            PG8_LDB(B1, 0, 1); PG8_STAGE(PG8_SB(0, 0), b2, voffB);
            PG8_BAR; PG8_WAIT_L(0); PG8_MMA(0, 1, At, B1); PG8_BAR;
            PG8_LDA(At, 0, 1); PG8_STAGE(PG8_SA(0, 0), a2, voffA);
            PG8_BAR; PG8_WAIT_L(0); PG8_MMA(1, 0, At, B0); PG8_BAR; PG8_SCHED;
            PG8_STAGE(PG8_SB(0, 1), b2 + hstep, voffB);
            PG8_WAIT_V(6); PG8_BAR; PG8_MMA(1, 1, At, B1); PG8_BAR;
            PG8_LDB(B0, 1, 0); PG8_SCHED; PG8_LDA(At, 1, 0); PG8_STAGE(PG8_SA(0, 1), a2 + hstep, voffA);
            PG8_WAIT_L(8); PG8_BAR; PG8_WAIT_L(0); PG8_MMA(0, 0, At, B0); PG8_BAR; PG8_SCHED;
            PG8_LDB(B1, 1, 1); PG8_STAGE(PG8_SB(1, 0), b3, voffB);
            PG8_BAR; PG8_WAIT_L(0); PG8_MMA(0, 1, At, B1); PG8_BAR;
            PG8_LDA(At, 1, 1); PG8_STAGE(PG8_SA(1, 0), a3, voffA);
            PG8_BAR; PG8_WAIT_L(0); PG8_MMA(1, 0, At, B0); PG8_BAR; PG8_SCHED;
            PG8_STAGE(PG8_SB(1, 1), b3 + hstep, voffB);
            PG8_WAIT_V(6); PG8_BAR; PG8_MMA(1, 1, At, B1); PG8_BAR;
            }
        }
        if constexpr (ALIGN_EPI) { if (wr == 0) PG8_BAR; }
        if constexpr (!Epi::AFTER_DRAIN) { E(acc, cur, wr, wc, fr, fq); S.done(cur); }
        if (!has_next) break;
#pragma unroll
        for (int a = 0; a < 2; ++a)
#pragma unroll
            for (int b = 0; b < 2; ++b)
#pragma unroll
                for (int m = 0; m < 4; ++m)
#pragma unroll
                    for (int n = 0; n < 2; ++n) acc[a][b][m][n] = (f32x4){0.f, 0.f, 0.f, 0.f};
        cur = nxt; cA = nA; cB = nB; ++ui;
        if constexpr (ALIGN_EPI) { if (wr == 1) PG8_BAR; }
    }
    PG8_WAIT_V(0);
    if constexpr (!ALIGN_EPI) { if (wr == 0) PG8_BAR; }
    PG8_BAR;
    if constexpr (Epi::AFTER_DRAIN) { E.fused(acc, cur, wr, wc, fr, fq, lds, wid, lane); S.done(cur); }
#undef PG8_SA
#undef PG8_SB
#undef PG8_STAGE
#undef PG8_LDA
#undef PG8_LDB
#undef PG8_MMA
#undef PG8_WAIT_V
#undef PG8_WAIT_L
#undef PG8_BAR
#undef PG8_SCHED
}
}

#define LAS __attribute__((address_space(3)))
typedef unsigned short bf16;
typedef unsigned u32x4 __attribute__((ext_vector_type(4)));
typedef unsigned u32x2 __attribute__((ext_vector_type(2)));
typedef float f32x4 __attribute__((ext_vector_type(4)));
typedef float f32x2 __attribute__((ext_vector_type(2)));
typedef float f32x16 __attribute__((ext_vector_type(16)));
typedef short bf16x8 __attribute__((ext_vector_type(8)));
typedef short s16x4 __attribute__((ext_vector_type(4)));
typedef __bf16 bf16x2_t __attribute__((ext_vector_type(2)));
#define DI __device__ __forceinline__

DI unsigned pk2(float lo, float hi) { f32x2 v = {lo, hi}; bf16x2_t b = __builtin_convertvector(v, bf16x2_t); return __builtin_bit_cast(unsigned, b); }
DI float bflo(unsigned u) { return __uint_as_float(u << 16); }
DI float bfhi(unsigned u) { return __uint_as_float(u & 0xffff0000u); }
DI float wave_sum(float v) {
#pragma unroll
    for (int o = 1; o < 64; o <<= 1) v += __shfl_xor(v, o);
    return v;
}

constexpr int NB = 4, SEQ = 8192, DM = 1024, MROWS = NB * SEQ, DFF = 2816;
constexpr float LOG2E = 1.4426950408889634f;
constexpr float SC_A = 0.14724444602590306f;
constexpr float SC_64 = 0.18033688011112042f;
constexpr float ALPHA = 1.4142135623730951f;
constexpr int NWAVES = 8, NTHR = 512;
constexpr int LDS_BYTES = 147456;

constexpr size_t MiB = 1u << 20;
constexpr size_t WS_MOD = 0;
constexpr size_t WS_MISC = 256 * 1024;
constexpr size_t WS_BAR = 512 * 1024;
constexpr size_t WS_ROPE = 1 * MiB;
constexpr size_t WS_LF = 2 * MiB;
constexpr size_t WS_F = 3 * MiB;
constexpr size_t W_ABIN = 8 * MiB, W_UQ = 12 * MiB, W_UKV = 12 * MiB + 512 * 1024, W_ABOUT = 13 * MiB, W_CDIN = 15 * MiB, W_CDOUT = 21 * MiB;
constexpr size_t W_UP0 = 23 * MiB, W_UP1 = 34 * MiB, W_DN0 = 45 * MiB, W_DN1 = 51 * MiB;
constexpr size_t WS_U = 64 * MiB;
constexpr size_t WS_R1 = 128 * MiB, WS_R2 = 304 * MiB;
constexpr size_t WS_Y1 = WS_R1;
constexpr size_t WS_QA = 256 * MiB;
constexpr size_t WS_KV = 304 * MiB;
constexpr size_t WS_CQN = 368 * MiB, WS_CKVN = 384 * MiB, WS_KROPE = 392 * MiB;
constexpr size_t WS_G = WS_R1, WS_H = WS_R2;
constexpr size_t WS_QKV1 = WS_R1;
constexpr size_t WS_MRG1 = 320 * MiB;
constexpr size_t WS_END = 480 * MiB;

struct Params { const float* in[27]; float* out; unsigned char* ws; int lo, hi; };

__constant__ float INVF[16] = {1.0f, 0.5623413324356079f, 0.3162277638912201f, 0.17782793939113617f, 0.10000000149011612f, 0.05623413249850273f, 0.03162277489900589f,
    0.017782794311642647f, 0.009999999776482582f, 0.005623413249850273f, 0.003162277629598975f, 0.0017782794311642647f, 0.0010000000474974513f, 0.000562341301701963f,
    0.0003162277571391314f, 0.00017782794020604342f};

DI void tr_item(const float* W, int K, int Nsrc, int srccol0, bf16* WT, int n0, int k0, float sc, LAS float* scr, int lane) {
#pragma unroll 8
    for (int i = 0; i < 32; ++i) { const int kk = 2 * i + (lane >> 5);
        const float v = (srccol0 >= 0) ? W[(size_t)(k0 + kk) * Nsrc + srccol0 + (lane & 31)] : 0.f; scr[kk * 33 + (lane & 31)] = v * sc; }
    asm volatile("s_waitcnt lgkmcnt(0)" ::: "memory");
    const int c = lane & 7;
#pragma unroll
    for (int j = 0; j < 4; ++j) { const int n = (lane >> 3) + 8 * j; const LAS float* s = scr + (8 * c) * 33 + n;
        u32x4 o; o.x = pk2(s[0 * 33], s[1 * 33]); o.y = pk2(s[2 * 33], s[3 * 33]); o.z = pk2(s[4 * 33], s[5 * 33]); o.w = pk2(s[6 * 33], s[7 * 33]);
        *(u32x4*)(WT + (size_t)(n0 + n) * K + k0 + 8 * c) = o; }
    asm volatile("s_waitcnt lgkmcnt(0)" ::: "memory");
}

DI void p_prologue(const Params& p, LAS unsigned char* lds) {
    const int tid = threadIdx.x, lane = tid & 63, wave = tid >> 6, G = gridDim.x, bx = blockIdx.x;
    const float* c = p.in[1]; const float* ada_w = p.in[2]; const float* ada_b = p.in[3];
    float* MOD = (float*)(p.ws + WS_MOD);
    LAS float* cond = (LAS float*)lds;
    LAS float* red = (LAS float*)(lds + 16384);
    for (int i = tid; i < 4096; i += NTHR) { const float v = c[i]; cond[i] = v / (1.f + __expf(-v)); }
    __syncthreads();
    for (int it = bx; it < 192; it += G) {
        const int sub = it / 48, cb = it % 48, col = cb * 64 + lane;
        const float* w = ada_w + (size_t)sub * 1024 * 3072 + col;
        float a0 = 0.f, a1 = 0.f, a2 = 0.f, a3 = 0.f; const int kb = wave * 128;
#pragma unroll 8
        for (int k = 0; k < 128; ++k) { const float wv = w[(size_t)(kb + k) * 3072];
            a0 += cond[kb + k] * wv; a1 += cond[1024 + kb + k] * wv; a2 += cond[2048 + kb + k] * wv; a3 += cond[3072 + kb + k] * wv; }
        red[(wave * 4 + 0) * 64 + lane] = a0; red[(wave * 4 + 1) * 64 + lane] = a1; red[(wave * 4 + 2) * 64 + lane] = a2; red[(wave * 4 + 3) * 64 + lane] = a3;
        __syncthreads();
        if (tid < 256) { const int b = tid >> 6; float s = 0.f;
#pragma unroll
            for (int w8 = 0; w8 < 8; ++w8) s += red[(w8 * 4 + b) * 64 + lane];
            s += ada_b[sub * 3072 + col]; if (col >= 1024) s += 1.f;
            MOD[(sub * 4 + b) * 3072 + col] = s; }
        __syncthreads();
    }
    LAS float* scr = (LAS float*)(lds + 32768 + wave * 8448);
    const int gw = bx * NWAVES + wave, NGW = G * NWAVES;
    constexpr int NITEMS = 1024 + 96 + 64 + 512 + 1536 + 512 + 4 * 1408 + 2 * 1408;
    for (int it = gw; it < NITEMS; it += NGW) {
        int r = it; int job = 0;
        const int cnt[12] = {1024, 96, 64, 512, 1536, 512, 1408, 1408, 1408, 1408, 1408, 1408};
#pragma unroll
        for (int j = 0; j < 11; ++j) { if (job == j && r >= cnt[j]) { r -= cnt[j]; job = j + 1; } }
        const float* W; int K, Nsrc, Ndst; bf16* WT;
        switch (job) {
            case 0: W = p.in[7]; K = 1024; Nsrc = 1952; Ndst = 2048; WT = (bf16*)(p.ws + W_ABIN); break;
            case 1: W = p.in[9]; K = 256; Nsrc = 768; Ndst = 768; WT = (bf16*)(p.ws + W_UQ); break;
            case 2: W = p.in[11]; K = 128; Nsrc = 1024; Ndst = 1024; WT = (bf16*)(p.ws + W_UKV); break;
            case 3: W = p.in[17]; K = 1024; Nsrc = 1024; Ndst = 1024; WT = (bf16*)(p.ws + W_ABOUT); break;
            case 4: W = p.in[18]; K = 1024; Nsrc = 3080; Ndst = 3072; WT = (bf16*)(p.ws + W_CDIN); break;
            case 5: W = p.in[21]; K = 1024; Nsrc = 1024; Ndst = 1024; WT = (bf16*)(p.ws + W_CDOUT); break;
            case 6: W = p.in[22]; K = 1024; Nsrc = 2816; Ndst = 2816; WT = (bf16*)(p.ws + W_UP0); break;
            case 7: W = p.in[23]; K = 1024; Nsrc = 2816; Ndst = 2816; WT = (bf16*)(p.ws + W_UP0) + (size_t)2816 * 1024; break;
            case 8: W = p.in[22] + (size_t)1024 * 2816; K = 1024; Nsrc = 2816; Ndst = 2816; WT = (bf16*)(p.ws + W_UP1); break;
            case 9: W = p.in[23] + (size_t)1024 * 2816; K = 1024; Nsrc = 2816; Ndst = 2816; WT = (bf16*)(p.ws + W_UP1) + (size_t)2816 * 1024; break;
            case 10: W = p.in[26]; K = 2816; Nsrc = 1024; Ndst = 1024; WT = (bf16*)(p.ws + W_DN0); break;
            default: W = p.in[26] + (size_t)2816 * 1024; K = 2816; Nsrc = 1024; Ndst = 1024; WT = (bf16*)(p.ws + W_DN1); break;
        }
        const int nblk = Ndst / 32, kb = r / nblk, nb = r % nblk, n0 = nb * 32, k0 = kb * 64;
        int src = n0; float sc = 1.f;
        if (job == 0) { src = (n0 < 1952) ? n0 : -1; if (n0 >= 416 && n0 < 928) sc = SC_64; }
        else if (job == 1) { src = (n0 < 512) ? (n0 >> 6) * 96 + (n0 & 63) : ((n0 - 512) >> 5) * 96 + 64; sc = SC_A; }
        else if (job == 2) { src = (n0 < 512) ? (n0 >> 6) * 128 + (n0 & 63) : ((n0 - 512) >> 6) * 128 + 64 + ((n0 - 512) & 63); }
        else if (job == 4) { src = (n0 < 1536) ? n0 : n0 + 8; if (n0 < 512 || (n0 >= 1536 && n0 < 2048)) sc = SC_64; }
        tr_item(W, K, Nsrc, src, WT, n0, k0, sc, scr, lane);
    }
    float* ROPE = (float*)(p.ws + WS_ROPE);
    for (int i = bx * NTHR + tid; i < SEQ * 16; i += G * NTHR) {
        const int pos = i >> 4, fi = i & 15;
        const float ang = (float)pos * INVF[fi];
        const double a = (double)ang, TWO_PI = 6.283185307179586476925;
        const double n = __builtin_rint(a * (1.0 / TWO_PI));
        const double x = a - n * TWO_PI, x2 = x * x;
        double sn = 1.0, cs = 1.0;
#pragma unroll
        for (int k = 13; k >= 1; --k) { sn = 1.0 - sn * x2 / (double)((2 * k) * (2 * k + 1)); cs = 1.0 - cs * x2 / (double)((2 * k - 1) * (2 * k)); }
        ROPE[i] = (float)cs; ROPE[SEQ * 16 + i] = (float)(sn * x);
    }
    if (bx == 0 && tid == 0) {
        float d1 = 0.f, d2 = 0.f;
        for (int i = 0; i < 64; ++i) { d1 += p.in[12][i] * p.in[13][i]; d2 += p.in[14][i] * p.in[15][i]; }
        ((float*)(p.ws + WS_MISC))[0] = expf(d1) - expf(d2) + 0.2f;
    }
}

DI void p_modulate(const Params& p) {
    const int tid = threadIdx.x, lane = tid & 63, wave = tid >> 6;
    const int gw = blockIdx.x * NWAVES + wave, NGW = gridDim.x * NWAVES;
    const float* x = p.in[0]; const float* MOD = (const float*)(p.ws + WS_MOD); bf16* U = (bf16*)(p.ws + WS_U);
    for (int row = gw; row < MROWS; row += NGW) {
        const int b = row >> 13; const float* mb = MOD + (size_t)b * 3072;
#pragma unroll
        for (int j = 0; j < 4; ++j) { const int col = 4 * lane + 256 * j;
            const f32x4 v = *(const f32x4*)(x + (size_t)row * DM + col), sh = *(const f32x4*)(mb + col), sc = *(const f32x4*)(mb + 1024 + col);
            const f32x4 u = v * sc + sh; u32x2 o; o.x = pk2(u[0], u[1]); o.y = pk2(u[2], u[3]);
            *(u32x2*)(U + (size_t)row * DM + col) = o; }
    }
}

DI void p_norm3(const Params& p) {
    const int tid = threadIdx.x, lane = tid & 63, wave = tid >> 6;
    const int gw = blockIdx.x * NWAVES + wave, NGW = gridDim.x * NWAVES;
    const bf16* Y1 = (const bf16*)(p.ws + WS_Y1); bf16* CQN = (bf16*)(p.ws + WS_CQN); bf16* CKVN = (bf16*)(p.ws + WS_CKVN); bf16* KR = (bf16*)(p.ws + WS_KROPE);
    const float* ROPE = (const float*)(p.ws + WS_ROPE);
    const f32x4 qg = *(const f32x4*)(p.in[8] + 4 * lane); const f32x2 kg = *(const f32x2*)(p.in[10] + 2 * lane);
    for (int row = gw; row < MROWS; row += NGW) {
        const bf16* yr = Y1 + (size_t)row * 2048;
        const u32x2 a = *(const u32x2*)(yr + 4 * lane); const unsigned kvv = *(const unsigned*)(yr + 256 + 2 * lane);
        float v0 = bflo(a.x), v1 = bfhi(a.x), v2 = bflo(a.y), v3 = bfhi(a.y);
        float ss = wave_sum(v0 * v0 + v1 * v1 + v2 * v2 + v3 * v3);
        float rs = 1.0f / sqrtf(ss * (1.f / 256.f) + 1e-6f);
        u32x2 o; o.x = pk2(v0 * rs * qg[0], v1 * rs * qg[1]); o.y = pk2(v2 * rs * qg[2], v3 * rs * qg[3]);
        *(u32x2*)(CQN + (size_t)row * 256 + 4 * lane) = o;
        float w0 = bflo(kvv), w1 = bfhi(kvv);
        ss = wave_sum(w0 * w0 + w1 * w1); rs = 1.0f / sqrtf(ss * (1.f / 128.f) + 1e-6f);
        *(unsigned*)(CKVN + (size_t)row * 128 + 2 * lane) = pk2(w0 * rs * kg[0], w1 * rs * kg[1]);
        if (lane < 16) { const int pos = row & (SEQ - 1);
            const float x1 = bflo((unsigned)yr[384 + lane]), x2 = bflo((unsigned)yr[400 + lane]);
            const float cs = ROPE[pos * 16 + lane], sn = ROPE[SEQ * 16 + pos * 16 + lane];
            KR[(size_t)row * 32 + lane] = (bf16)(pk2(x1 * cs - x2 * sn, 0.f) & 0xffffu);
            KR[(size_t)row * 32 + 16 + lane] = (bf16)(pk2(x1 * sn + x2 * cs, 0.f) & 0xffffu); }
    }
}

DI void p_ln(const Params& p, int lnidx, int next_sub, bool do_fl) {
    const int tid = threadIdx.x, lane = tid & 63, wave = tid >> 6;
    const int gw = blockIdx.x * NWAVES + wave, NGW = gridDim.x * NWAVES;
    float* X = p.out; const float* g = p.in[4] + lnidx * 1024; const float* bt = p.in[5] + lnidx * 1024;
    const float* MOD = (const float*)(p.ws + WS_MOD); bf16* U = (bf16*)(p.ws + WS_U);
    const float* wf = p.in[18] + 1536; const float* bfv = p.in[19]; float* LF = (float*)(p.ws + WS_LF);
    for (int row = gw; row < MROWS; row += NGW) {
        const int b = row >> 13;
        f32x4 v[4]; float s = 0.f;
#pragma unroll
        for (int j = 0; j < 4; ++j) { v[j] = *(const f32x4*)(X + (size_t)row * DM + 4 * lane + 256 * j); s += (v[j][0] + v[j][1]) + (v[j][2] + v[j][3]); }
        const float mean = wave_sum(s) * (1.f / 1024.f); float s2 = 0.f;
#pragma unroll
        for (int j = 0; j < 4; ++j) { v[j] = v[j] - mean; s2 += (v[j][0] * v[j][0] + v[j][1] * v[j][1]) + (v[j][2] * v[j][2] + v[j][3] * v[j][3]); }
        const float rstd = 1.0f / sqrtf(wave_sum(s2) * (1.f / 1024.f) + 1e-5f);
        float fa[8] = {0.f, 0.f, 0.f, 0.f, 0.f, 0.f, 0.f, 0.f};
#pragma unroll
        for (int j = 0; j < 4; ++j) { const int col = 4 * lane + 256 * j;
            const f32x4 xn = v[j] * rstd * *(const f32x4*)(g + col) + *(const f32x4*)(bt + col);
            *(f32x4*)(X + (size_t)row * DM + col) = xn;
            if (next_sub >= 0) { const float* mb = MOD + (size_t)(next_sub * 4 + b) * 3072;
                const f32x4 u = xn * *(const f32x4*)(mb + 1024 + col) + *(const f32x4*)(mb + col);
                u32x2 o; o.x = pk2(u[0], u[1]); o.y = pk2(u[2], u[3]); *(u32x2*)(U + (size_t)row * DM + col) = o;
                if (do_fl) {
#pragma unroll
                    for (int e = 0; e < 4; ++e) { const f32x4 w0 = *(const f32x4*)(wf + (size_t)(col + e) * 3080), w1 = *(const f32x4*)(wf + (size_t)(col + e) * 3080 + 4);
                        fa[0] += u[e] * w0[0]; fa[1] += u[e] * w0[1]; fa[2] += u[e] * w0[2]; fa[3] += u[e] * w0[3];
                        fa[4] += u[e] * w1[0]; fa[5] += u[e] * w1[1]; fa[6] += u[e] * w1[2]; fa[7] += u[e] * w1[3]; } } }
        }
        if (do_fl) {
#pragma unroll
            for (int h = 0; h < 8; ++h) fa[h] = wave_sum(fa[h]);
            if (lane < 8) {
                float xv = fa[0];
#pragma unroll
                for (int h = 1; h < 8; ++h) xv = (lane == h) ? fa[h] : xv;
                xv += bfv[lane];
                const float lf = fminf(xv, 0.f) - log1pf(expf(-fabsf(xv)));
                LF[(size_t)(b * 8 + lane) * SEQ + (row & (SEQ - 1))] = lf; }
        }
    }
}

DI void p_conv(const Params& p, int layer) {
    const bf16* Gb = (const bf16*)(p.ws + WS_G); bf16* Hb = (bf16*)(p.ws + WS_H);
    const float* cw = p.in[24] + (size_t)layer * 3 * DFF; const float* cbv = p.in[25] + (size_t)layer * DFF;
    const int total = (MROWS / 32) * (DFF / 8);
    for (int it = blockIdx.x * NTHR + threadIdx.x; it < total; it += gridDim.x * NTHR) {
        const int rb = it / (DFF / 8), ch = it % (DFF / 8), row0 = rb * 32, c0 = ch * 8;
        float w0[8], w1[8], w2[8], cb[8], gm2[8], gm1[8];
#pragma unroll
        for (int h = 0; h < 2; ++h) { const f32x4 a = *(const f32x4*)(cw + c0 + 4 * h), b = *(const f32x4*)(cw + DFF + c0 + 4 * h), c = *(const f32x4*)(cw + 2 * DFF + c0 + 4 * h), d = *(const f32x4*)(cbv + c0 + 4 * h);
#pragma unroll
            for (int e = 0; e < 4; ++e) { w0[4 * h + e] = a[e]; w1[4 * h + e] = b[e]; w2[4 * h + e] = c[e]; cb[4 * h + e] = d[e]; } }
        if ((row0 & (SEQ - 1)) == 0) {
#pragma unroll
            for (int e = 0; e < 8; ++e) { gm2[e] = 0.f; gm1[e] = 0.f; }
        } else {
            const u32x4 a = *(const u32x4*)(Gb + (size_t)(row0 - 2) * DFF + c0), b = *(const u32x4*)(Gb + (size_t)(row0 - 1) * DFF + c0);
#pragma unroll
            for (int e = 0; e < 4; ++e) { gm2[2 * e] = bflo(a[e]); gm2[2 * e + 1] = bfhi(a[e]); gm1[2 * e] = bflo(b[e]); gm1[2 * e + 1] = bfhi(b[e]); }
        }
#pragma unroll 4
        for (int r = 0; r < 32; ++r) {
            const size_t off = (size_t)(row0 + r) * DFF + c0;
            const u32x4 gv = *(const u32x4*)(Gb + off), vv = *(const u32x4*)(Hb + off);
            float g0[8], hv[8];
#pragma unroll
            for (int e = 0; e < 4; ++e) { g0[2 * e] = bflo(gv[e]); g0[2 * e + 1] = bfhi(gv[e]); }
#pragma unroll
            for (int e = 0; e < 8; ++e) { const float pre = w0[e] * gm2[e] + w1[e] * gm1[e] + w2[e] * g0[e] + cb[e];
                const float sl = pre * __builtin_amdgcn_rcpf(1.f + __expf(-pre)); const float vval = (e & 1) ? bfhi(vv[e >> 1]) : bflo(vv[e >> 1]);
                hv[e] = sl * vval; gm2[e] = gm1[e]; gm1[e] = g0[e]; }
            u32x4 o; o.x = pk2(hv[0], hv[1]); o.y = pk2(hv[2], hv[3]); o.z = pk2(hv[4], hv[5]); o.w = pk2(hv[6], hv[7]);
            *(u32x4*)(Hb + off) = o;
        }
    }
}

DI void p_scan(const Params& p, LAS unsigned char* lds) {
    if (blockIdx.x >= 32) return;
    const int tid = threadIdx.x, lane = tid & 63, wave = tid >> 6;
    const float* LF = (const float*)(p.ws + WS_LF) + (size_t)blockIdx.x * SEQ; float* F = (float*)(p.ws + WS_F) + (size_t)blockIdx.x * SEQ;
    LAS float* wsum = (LAS float*)lds;
    f32x4 v[4]; float s = 0.f;
#pragma unroll
    for (int j = 0; j < 4; ++j) { v[j] = *(const f32x4*)(LF + tid * 16 + 4 * j);
#pragma unroll
        for (int e = 0; e < 4; ++e) { s += v[j][e]; v[j][e] = s; } }
    float inc = s;
#pragma unroll
    for (int o = 1; o < 64; o <<= 1) { const float t = __shfl_up(inc, o); if (lane >= o) inc += t; }
    if (lane == 63) wsum[wave] = inc;
    __syncthreads();
    float off = inc - s;
#pragma unroll
    for (int w = 0; w < 8; ++w) off += (w < wave) ? wsum[w] : 0.f;
#pragma unroll
    for (int j = 0; j < 4; ++j) *(f32x4*)(F + tid * 16 + 4 * j) = v[j] + off;
    __syncthreads();
}

struct EpiResid {
    static constexpr bool PERM = true, AFTER_DRAIN = false;
    const float* xin; float* xout; const float* gate;
    __device__ __forceinline__ void operator()(const pg8::f32x4 (&acc)[2][2][4][2], const pg8::Unit& u, int wr, int wc, int fr, int fq) const {
        const int row0 = u.pm * 256 + wr * 64 + fr, col0 = u.pn * 256 + wc * 32 + 8 * fq, b = (u.pm * 256) >> 13;
        f32x4 gv[2][2];
#pragma unroll
        for (int bj = 0; bj < 2; ++bj)
#pragma unroll
            for (int n = 0; n < 2; ++n) gv[bj][n] = *(const f32x4*)(gate + (size_t)b * 3072 + col0 + bj * 128 + 4 * n);
#pragma unroll
        for (int ai = 0; ai < 2; ++ai)
#pragma unroll
            for (int m = 0; m < 4; ++m) { const size_t off = (size_t)(row0 + ai * 128 + m * 16) * DM + col0;
#pragma unroll
                for (int bj = 0; bj < 2; ++bj)
#pragma unroll
                    for (int n = 0; n < 2; ++n) { const f32x4 xi = *(const f32x4*)(xin + off + bj * 128 + 4 * n);
                        const f32x4 o = xi * ALPHA + gv[bj][n] * acc[ai][bj][m][n]; *(f32x4*)(xout + off + bj * 128 + 4 * n) = o; } }
    }
};

namespace att {
constexpr int KBUF = 64 * 208, VBUF = 64 * 272;
constexpr int OFF_K = 0, OFF_V = 2 * KBUF, OFF_KB = 2 * KBUF + 2 * VBUF, OFF_TAB = OFF_KB + 512, LDS_END = OFF_TAB + 1024;
constexpr float NEG = -1e30f;
struct Src { const float* rope; const bf16* q; const bf16* q2; int qpitch; const bf16* k; const bf16* k2; int kpitch; const bf16* v; int vpitch; const float* f; float fref; };
#define MFMA32(a, b, c) __builtin_amdgcn_mfma_f32_32x32x16_bf16((a), (b), (c), 0, 0, 0)
typedef short v4i16_t __attribute__((ext_vector_type(4)));
DI s16x4 vtr(LAS unsigned char* ptr) { return __builtin_bit_cast(s16x4, __builtin_amdgcn_ds_read_tr16_b64_v4i16((LAS v4i16_t*)ptr)); }

template <int DQK, int DV, int MODE>
DI void core(LAS unsigned char* lds, const Src& s, int q0, int TLO, int THI, int tlo_w, int thi_w, int near_lo, float farc, f32x16 (&o)[DV / 32], float& l_out) {
    constexpr int KROW = DQK * 2 + 16, VROW = DV * 2 + 16, ND = DQK / 16, NC = DV / 32;
    const int tid = threadIdx.x, lane = tid & 63, r = lane & 31, h = lane >> 5;
    const int wid = __builtin_amdgcn_readfirstlane(tid >> 6);
    bf16x8 qf[ND];
    { const bf16* qp = s.q + (size_t)(q0 + 32 * wid + r) * s.qpitch + 8 * h;
#pragma unroll
      for (int d0 = 0; d0 < 4; ++d0) qf[d0] = *(const bf16x8*)(qp + 16 * d0);
      if constexpr (DQK == 96) { const bf16* q2p = s.q2 + (size_t)(q0 + 32 * wid + r) * s.qpitch + 8 * h;
          const u32x4 x1 = *(const u32x4*)(q2p), x2 = *(const u32x4*)(q2p + 16);
          const float* rp = s.rope + (size_t)(q0 + 32 * wid + r) * 16 + 8 * h;
          const f32x4 c0 = *(const f32x4*)(rp), c1 = *(const f32x4*)(rp + 4), s0 = *(const f32x4*)(rp + SEQ * 16), s1 = *(const f32x4*)(rp + SEQ * 16 + 4);
          u32x4 y1, y2;
#pragma unroll
          for (int e = 0; e < 4; ++e) { const float a0 = bflo(x1[e]), a1 = bfhi(x1[e]), b0 = bflo(x2[e]), b1 = bfhi(x2[e]);
              const float cl = e < 2 ? c0[2 * e] : c1[2 * e - 4], ch = e < 2 ? c0[2 * e + 1] : c1[2 * e - 3], sl = e < 2 ? s0[2 * e] : s1[2 * e - 4], sh = e < 2 ? s0[2 * e + 1] : s1[2 * e - 3];
              y1[e] = pk2(a0 * cl - b0 * sl, a1 * ch - b1 * sh); y2[e] = pk2(a0 * sl + b0 * cl, a1 * sh + b1 * ch); }
          qf[4] = __builtin_bit_cast(bf16x8, y1); qf[5] = __builtin_bit_cast(bf16x8, y2); } }
#pragma unroll
    for (int c = 0; c < NC; ++c)
#pragma unroll
        for (int i = 0; i < 16; ++i) o[c][i] = 0.f;
    float m_run = NEG, l_run = 0.f;
    u32x4 kr, k2r, vr0, vr1; float fr_ = 0.f;
    kr = (u32x4){0u, 0u, 0u, 0u}; k2r = kr; vr0 = kr; vr1 = kr;
#define ATT_ISSUE(t) do { const size_t key0 = (size_t)(t) * 64; \
        kr = *(const u32x4*)(s.k + (key0 + (tid >> 3)) * s.kpitch + (tid & 7) * 8); \
        if constexpr (DQK == 96) { if (tid < 256) k2r = *(const u32x4*)(s.k2 + (key0 + (tid >> 2)) * 32 + (tid & 3) * 8); } \
        if constexpr (DV == 64) { vr0 = *(const u32x4*)(s.v + (key0 + (tid >> 3)) * s.vpitch + (tid & 7) * 8); } \
        else { vr0 = *(const u32x4*)(s.v + (key0 + (tid >> 4)) * s.vpitch + (tid & 15) * 8); vr1 = *(const u32x4*)(s.v + (key0 + 32 + (tid >> 4)) * s.vpitch + (tid & 15) * 8); } \
        if constexpr (MODE == 2) { if (tid < 64) fr_ = s.f[key0 + tid]; } } while (0)
#define ATT_COMMIT(buf) do { LAS unsigned char* kb_ = lds + OFF_K + (buf) * KBUF; LAS unsigned char* vb_ = lds + OFF_V + (buf) * VBUF; \
        *(LAS u32x4*)(kb_ + (tid >> 3) * KROW + (tid & 7) * 16) = kr; \
        if constexpr (DQK == 96) { if (tid < 256) *(LAS u32x4*)(kb_ + (tid >> 2) * KROW + 128 + (tid & 3) * 16) = k2r; } \
        if constexpr (DV == 64) { *(LAS u32x4*)(vb_ + (tid >> 3) * VROW + (tid & 7) * 16) = vr0; } \
        else { *(LAS u32x4*)(vb_ + (tid >> 4) * VROW + (tid & 15) * 16) = vr0; *(LAS u32x4*)(vb_ + (32 + (tid >> 4)) * VROW + (tid & 15) * 16) = vr1; } \
        if constexpr (MODE == 2) { if (tid < 64) ((LAS float*)(lds + OFF_KB))[(buf) * 64 + tid] = (s.fref - fr_) * LOG2E; } } while (0)
    const int i16 = lane & 15, q4 = i16 >> 2, pp = i16 & 3, blk = (lane >> 4) & 1;
    const int voff = (4 * h + q4) * VROW + blk * 32 + pp * 8;
    ATT_ISSUE(TLO); ATT_COMMIT(0);
    __syncthreads();
    for (int t = TLO; t <= THI; ++t) {
        const int buf = (t - TLO) & 1;
        if (t < THI) ATT_ISSUE(t + 1);
        if (t >= tlo_w && t <= thi_w) {
            LAS unsigned char* kb = lds + OFF_K + buf * KBUF; LAS unsigned char* vb = lds + OFF_V + buf * VBUF;
            f32x16 p0, p1;
#pragma unroll
            for (int i = 0; i < 16; ++i) { p0[i] = 0.f; p1[i] = 0.f; }
#pragma unroll
            for (int d0 = 0; d0 < ND; ++d0) {
                const bf16x8 k0 = *(const LAS bf16x8*)(kb + r * KROW + d0 * 32 + h * 16);
                const bf16x8 k1 = *(const LAS bf16x8*)(kb + (32 + r) * KROW + d0 * 32 + h * 16);
                p0 = MFMA32(k0, qf[d0], p0); p1 = MFMA32(k1, qf[d0], p1);
            }
            if constexpr (MODE == 1) {
                if (t >= near_lo) {
                    const LAS float* tab = (const LAS float*)(lds + OFF_TAB);
                    const int base = (q0 + 32 * wid + r) - 64 * t + 63 - 4 * h;
#pragma unroll
                    for (int i = 0; i < 16; ++i) { const int kk = (i & 3) + 8 * (i >> 2); p0[i] += tab[base - kk]; p1[i] += tab[base - 32 - kk]; }
                } else {
#pragma unroll
                    for (int i = 0; i < 16; ++i) { p0[i] += farc; p1[i] += farc; }
                }
            }
            if constexpr (MODE == 2) {
                const LAS float* kbp = (const LAS float*)(lds + OFF_KB) + buf * 64;
#pragma unroll
                for (int g = 0; g < 4; ++g) { const f32x4 b0 = *(const LAS f32x4*)(kbp + 8 * g + 4 * h), b1 = *(const LAS f32x4*)(kbp + 32 + 8 * g + 4 * h);
#pragma unroll
                    for (int e = 0; e < 4; ++e) { p0[4 * g + e] += b0[e]; p1[4 * g + e] += b1[e]; } }
                if (t == thi_w) { const int qq = 32 * (wid & 1) + r;
#pragma unroll
                    for (int i = 0; i < 16; ++i) { const int kk = (i & 3) + 8 * (i >> 2) + 4 * h; if (kk > qq) p0[i] = NEG; if (kk + 32 > qq) p1[i] = NEG; } }
            }
            float rm = p0[0];
#pragma unroll
            for (int i = 1; i < 16; ++i) rm = fmaxf(rm, p0[i]);
#pragma unroll
            for (int i = 0; i < 16; ++i) rm = fmaxf(rm, p1[i]);
            rm = fmaxf(rm, __shfl_xor(rm, 32));
            const float mn = fmaxf(m_run, rm), alpha = __builtin_amdgcn_exp2f(m_run - mn); m_run = mn;
            float rs = 0.f;
#pragma unroll
            for (int i = 0; i < 16; ++i) { p0[i] = __builtin_amdgcn_exp2f(p0[i] - mn); p1[i] = __builtin_amdgcn_exp2f(p1[i] - mn); rs += p0[i] + p1[i]; }
            l_run = l_run * alpha + rs;
            if (__any(alpha != 1.f)) {
#pragma unroll
                for (int c = 0; c < NC; ++c)
#pragma unroll
                    for (int i = 0; i < 16; ++i) o[c][i] *= alpha;
            }
            bf16x8 pa[4];
            { u32x4 w;
              w.x = pk2(p0[0], p0[1]); w.y = pk2(p0[2], p0[3]); w.z = pk2(p0[4], p0[5]); w.w = pk2(p0[6], p0[7]); pa[0] = __builtin_bit_cast(bf16x8, w);
              w.x = pk2(p0[8], p0[9]); w.y = pk2(p0[10], p0[11]); w.z = pk2(p0[12], p0[13]); w.w = pk2(p0[14], p0[15]); pa[1] = __builtin_bit_cast(bf16x8, w);
              w.x = pk2(p1[0], p1[1]); w.y = pk2(p1[2], p1[3]); w.z = pk2(p1[4], p1[5]); w.w = pk2(p1[6], p1[7]); pa[2] = __builtin_bit_cast(bf16x8, w);
              w.x = pk2(p1[8], p1[9]); w.y = pk2(p1[10], p1[11]); w.z = pk2(p1[12], p1[13]); w.w = pk2(p1[14], p1[15]); pa[3] = __builtin_bit_cast(bf16x8, w); }
#pragma unroll
            for (int c = 0; c < NC; ++c)
#pragma unroll
                for (int ks = 0; ks < 4; ++ks) {
                    const s16x4 lo = vtr(vb + voff + ks * 16 * VROW + c * 64), hi = vtr(vb + voff + ks * 16 * VROW + 8 * VROW + c * 64);
                    const bf16x8 vf = __builtin_shufflevector(lo, hi, 0, 1, 2, 3, 4, 5, 6, 7);
                    o[c] = MFMA32(vf, pa[ks], o[c]);
                }
        }
        if (t < THI) ATT_COMMIT(buf ^ 1);
        __syncthreads();
    }
#undef ATT_ISSUE
#undef ATT_COMMIT
    l_out = l_run + __shfl_xor(l_run, 32);
}

DI int t5_bucket(int rel) {
    const int n = rel < 0 ? -rel : rel; int b;
    if (n < 8) b = n; else if (n < 12) b = 8; else if (n < 16) b = 9; else if (n < 23) b = 10; else if (n < 32) b = 11; else if (n < 46) b = 12; else if (n < 64) b = 13; else if (n < 91) b = 14; else b = 15;
    return (rel > 0 ? 16 : 0) + b;
}
template <int NC> DI void store_o(const f32x16 (&o)[NC], float inv, bf16* O, int h) {
#pragma unroll
    for (int c = 0; c < NC; ++c)
#pragma unroll
        for (int g = 0; g < 4; ++g) { u32x2 w; w.x = pk2(o[c][4 * g] * inv, o[c][4 * g + 1] * inv); w.y = pk2(o[c][4 * g + 2] * inv, o[c][4 * g + 3] * inv);
            *(u32x2*)(O + 32 * c + 8 * g + 4 * h) = w; }
}

DI void phase_ab(const Params& p, LAS unsigned char* lds, int vcu, int G) {
    const int tid = threadIdx.x, lane = tid & 63, r = lane & 31, h = lane >> 5, wid = __builtin_amdgcn_readfirstlane(tid >> 6);
    const bf16* QA = (const bf16*)(p.ws + WS_QA); const bf16* KV = (const bf16*)(p.ws + WS_KV); const bf16* KR = (const bf16*)(p.ws + WS_KROPE);
    const bf16* Y1 = (const bf16*)(p.ws + WS_Y1); bf16* MRG = (bf16*)(p.ws + WS_U);
    for (int i = 0;; ++i) {
        const int idx = i * G + vcu; if (idx >= 1024) break;
        const int slot = idx >> 8, v = idx & 255, bh = v >> 3, sx = v & 7, b = bh >> 3, hd = bh & 7;
        const int qb = slot == 0 ? sx : slot == 1 ? 15 - sx : slot == 2 ? 16 + sx : 31 - sx;
        Src s; s.rope = (const float*)(p.ws + WS_ROPE); s.q = QA + (size_t)b * SEQ * 768 + hd * 64; s.q2 = QA + (size_t)b * SEQ * 768 + 512 + hd * 32; s.qpitch = 768;
        s.k = KV + (size_t)b * SEQ * 1024 + hd * 64; s.k2 = KR + (size_t)b * SEQ * 32; s.kpitch = 1024; s.v = KV + (size_t)b * SEQ * 1024 + 512 + hd * 64; s.vpitch = 1024; s.f = nullptr; s.fref = 0.f;
        f32x16 o[2]; float l;
        core<96, 64, 0>(lds, s, qb * 256, 0, 4 * qb + 3, 0, 4 * qb + (wid >> 1), 0, 0.f, o, l);
        store_o<2>(o, 1.0f / l, MRG + (size_t)(b * SEQ + qb * 256 + 32 * wid + r) * DM + hd * 64, h);
    }
    const float lam = ((const float*)(p.ws + WS_MISC))[0];
    for (int i = 0;; ++i) {
        const int idx = i * G + vcu; if (idx >= 512) break;
        const int slot = idx >> 8, v = idx & 255, bh = v >> 4, sx = v & 15, b = bh >> 2, hb = bh & 3;
        const int qb = slot == 0 ? sx : 31 - sx;
        if (tid < 255) ((LAS float*)(lds + OFF_TAB))[tid] = p.in[6][hb * 32 + t5_bucket(63 - tid)] * LOG2E;
        const float farc = p.in[6][hb * 32 + 15] * LOG2E;
        bf16* O = MRG + (size_t)(b * SEQ + qb * 256 + 32 * wid + r) * DM + 512 + hb * 128;
#pragma unroll
        for (int comp = 0; comp < 2; ++comp) {
            Src s; s.rope = nullptr; const bf16* yb = Y1 + (size_t)b * SEQ * 2048;
            s.q = yb + 416 + hb * 128 + comp * 64; s.q2 = nullptr; s.qpitch = 2048; s.k = yb + 928 + hb * 128 + comp * 64; s.k2 = nullptr; s.kpitch = 2048;
            s.v = yb + 1440 + hb * 128; s.vpitch = 2048; s.f = nullptr; s.fref = 0.f;
            f32x16 o[4]; float l; const int cw = 4 * qb + (wid >> 1);
            core<64, 128, 1>(lds, s, qb * 256, 0, 4 * qb + 3, 0, cw, cw - 2, farc, o, l);
            const float inv = 1.0f / l;
            if (comp == 0) {
                store_o<4>(o, inv, O, h);
            } else {
                const float li = lam * inv; float ss = 0.f;
#pragma unroll
                for (int c = 0; c < 4; ++c)
#pragma unroll
                    for (int g = 0; g < 4; ++g) { const u32x2 w0 = *(const u32x2*)(O + 32 * c + 8 * g + 4 * h);
                        o[c][4 * g] = bflo(w0.x) - li * o[c][4 * g]; o[c][4 * g + 1] = bfhi(w0.x) - li * o[c][4 * g + 1];
                        o[c][4 * g + 2] = bflo(w0.y) - li * o[c][4 * g + 2]; o[c][4 * g + 3] = bfhi(w0.y) - li * o[c][4 * g + 3];
                        ss += (o[c][4 * g] * o[c][4 * g] + o[c][4 * g + 1] * o[c][4 * g + 1]) + (o[c][4 * g + 2] * o[c][4 * g + 2] + o[c][4 * g + 3] * o[c][4 * g + 3]); }
                ss += __shfl_xor(ss, 32);
                const float rstd = 0.8f / sqrtf(ss * (1.f / 128.f) + 1e-6f);
#pragma unroll
                for (int c = 0; c < 4; ++c)
#pragma unroll
                    for (int g = 0; g < 4; ++g) { const f32x4 sg = *(const f32x4*)(p.in[16] + 32 * c + 8 * g + 4 * h);
                        u32x2 w; w.x = pk2(o[c][4 * g] * rstd * sg[0], o[c][4 * g + 1] * rstd * sg[1]); w.y = pk2(o[c][4 * g + 2] * rstd * sg[2], o[c][4 * g + 3] * rstd * sg[3]);
                        *(u32x2*)(O + 32 * c + 8 * g + 4 * h) = w; }
            }
        }
    }
}

DI void phase_cd(const Params& p, LAS unsigned char* lds, int vcu, int G) {
    const int tid = threadIdx.x, lane = tid & 63, r = lane & 31, h = lane >> 5, wid = __builtin_amdgcn_readfirstlane(tid >> 6);
    const bf16* QKV = (const bf16*)(p.ws + WS_QKV1); bf16* MRG = (bf16*)(p.ws + WS_MRG1); const float* F = (const float*)(p.ws + WS_F);
    for (int i = 0;; ++i) {
        const int idx = i * G + vcu; if (idx >= 1024) break;
        const int slot = idx >> 8, v = idx & 255, bh = v >> 3, sx = v & 7, b = bh >> 3, hd = bh & 7;
        const int qb = slot == 0 ? sx : slot == 1 ? 15 - sx : slot == 2 ? 16 + sx : 31 - sx;
        const bf16* yb = QKV + (size_t)b * SEQ * 3072;
        Src s; s.rope = nullptr; s.q = yb + hd * 64; s.q2 = nullptr; s.qpitch = 3072; s.k = yb + 512 + hd * 64; s.k2 = nullptr; s.kpitch = 3072; s.v = yb + 1024 + hd * 64; s.vpitch = 3072;
        s.f = F + (size_t)bh * SEQ; s.fref = s.f[qb * 256];
        f32x16 o[2]; float l;
        core<64, 64, 2>(lds, s, qb * 256, 0, 4 * qb + 3, 0, 4 * qb + (wid >> 1), 0, 0.f, o, l);
        store_o<2>(o, 1.0f / l, MRG + (size_t)(b * SEQ + qb * 256 + 32 * wid + r) * DM + hd * 64, h);
    }
    for (int i = 0;; ++i) {
        const int idx = i * G + vcu; if (idx >= 1024) break;
        const int slot = idx >> 8, v = idx & 255, bh = v >> 3, sx = v & 7, b = bh >> 3, hd = bh & 7;
        const int qb = 4 * sx + slot;
        const float* rt = p.in[20] + hd * 257;
        if (tid < 255) { int d = tid - 63; d = d < -128 ? -128 : (d > 128 ? 128 : d); ((LAS float*)(lds + OFF_TAB))[tid] = rt[d + 128] * LOG2E; }
        const float farc = rt[256] * LOG2E;
        const bf16* yb = QKV + (size_t)b * SEQ * 3072;
        Src s; s.rope = nullptr; s.q = yb + 1536 + hd * 64; s.q2 = nullptr; s.qpitch = 3072; s.k = yb + 2048 + hd * 64; s.k2 = nullptr; s.kpitch = 3072; s.v = yb + 2560 + hd * 64; s.vpitch = 3072; s.f = nullptr; s.fref = 0.f;
        f32x16 o[2]; float l; const int cw = 4 * qb + (wid >> 1);
        const int TLO = (4 * qb - 8) > 0 ? (4 * qb - 8) : 0, tlo_w = (cw - 8) > 0 ? (cw - 8) : 0;
        core<64, 64, 1>(lds, s, qb * 256, TLO, 4 * qb + 3, tlo_w, cw, cw - 2, farc, o, l);
        store_o<2>(o, 1.0f / l, MRG + (size_t)(b * SEQ + qb * 256 + 32 * wid + r) * DM + 512 + hd * 64, h);
    }
}
}

#define XB_TMO      128
#define XB_XCNT(j)  (256  + 64 * (j))
#define XB_XSUB(j)  (1280 + 64 * (j))
#define XB_XGEN(j)  (2304 + 64 * (j))
#define XB_TOP      3328
#define XB_TOPGEN   3392
#define XCD_BAR_WORDS 3456
#define XB_SPIN_CAP (1u << 18)

__device__ __forceinline__ unsigned xb_ld(unsigned* p)              { return __hip_atomic_load(p, __ATOMIC_RELAXED, __HIP_MEMORY_SCOPE_AGENT); }
__device__ __forceinline__ unsigned xb_add(unsigned* p, unsigned v) { return __hip_atomic_fetch_add(p, v, __ATOMIC_RELAXED, __HIP_MEMORY_SCOPE_AGENT); }
__device__ __forceinline__ unsigned xb_xcc_id() { return (unsigned)__builtin_amdgcn_s_getreg((3 << 11) | 20) & 0xFu; }
#define XB_SPIN(cond, bar) do { unsigned _sp = 0; while (cond) { __builtin_amdgcn_s_sleep(1); \
    if ((++_sp & 255u) == 0u) { if (xb_ld(&(bar)[XB_TMO])) break; if (_sp > XB_SPIN_CAP) { atomicAdd(&(bar)[XB_TMO], 1u); break; } } } } while (0)

struct XcdBarrier {
    unsigned* bar; unsigned x;
    volatile LAS unsigned* st;
};

__device__ __forceinline__ XcdBarrier xcd_barrier_post(unsigned* bar, volatile LAS unsigned* st) {
    XcdBarrier b; b.bar = bar; b.x = xb_xcc_id(); b.st = st;
    if (threadIdx.x == 0) (void)xb_add(&bar[XB_XCNT(b.x)], 1u);
    return b;
}
__device__ __forceinline__ void xcd_barrier_complete(unsigned* bar, unsigned x, unsigned& nloc, unsigned& nx) {
    const unsigned G = gridDim.x * gridDim.y * gridDim.z;
    unsigned sum, cnt, mine, sp = 0u;
    for (;;) {
        sum = 0u; cnt = 0u; mine = 0u;
#pragma unroll
        for (unsigned j = 0; j < 16; ++j) { const unsigned c = xb_ld(&bar[XB_XCNT(j)]); sum += c; cnt += (c > 0u) ? 1u : 0u; mine = (j == x) ? c : mine; }
        if (sum == G) break;
        __builtin_amdgcn_s_sleep(1);
        if ((++sp & 255u) == 0u) { if (xb_ld(&bar[XB_TMO])) break; if (sp > XB_SPIN_CAP) { atomicAdd(&bar[XB_TMO], 1u); break; } }
    }
    nloc = mine > 0u ? mine : 1u; nx = cnt > 0u ? cnt : 1u;
}

__device__ __forceinline__ void xcd_barrier(const XcdBarrier& b) {
    asm volatile("s_waitcnt vmcnt(0)" ::: "memory");
    __syncthreads();
    if (threadIdx.x == 0) {
        unsigned* bar = b.bar;
        __builtin_amdgcn_s_waitcnt(0);
        unsigned nloc = b.st[0], nx = b.st[1];
        if (nloc == 0u) { xcd_barrier_complete(bar, b.x, nloc, nx); b.st[0] = nloc; b.st[1] = nx; }
        const unsigned old = xb_add(&bar[XB_XSUB(b.x)], 1u);
        const unsigned gen = old / nloc;
        if (old + 1u == (gen + 1u) * nloc) {
            __builtin_amdgcn_fence(__ATOMIC_RELEASE, "agent");
            asm volatile("s_waitcnt vmcnt(0)" ::: "memory");
            const unsigned og = xb_add(&bar[XB_TOP], 1u);
            const unsigned tg = og / nx;
            if (og + 1u == (tg + 1u) * nx) xb_add(&bar[XB_TOPGEN], 1u);
            else XB_SPIN(xb_ld(&bar[XB_TOPGEN]) == tg, bar);
            __builtin_amdgcn_fence(__ATOMIC_ACQUIRE, "agent");
            xb_add(&bar[XB_XGEN(b.x)], 1u);
            asm volatile("s_waitcnt vmcnt(0)" ::: "memory");
        } else {
            XB_SPIN(xb_ld(&bar[XB_XGEN(b.x)]) == gen, bar);
            __builtin_amdgcn_fence(__ATOMIC_ACQUIRE, "agent");
            asm volatile("s_waitcnt vmcnt(0)" ::: "memory");
        }
    }
    __syncthreads();
}

constexpr int NPHASE = 20;
__global__ void __launch_bounds__(NTHR, 2) mega_fwd(Params p) {
    extern __shared__ __attribute__((aligned(16))) unsigned char lds_raw[];
    LAS unsigned char* lds = (LAS unsigned char*)lds_raw;
    cg::grid_group grid = cg::this_grid();
    const int G = gridDim.x, bx = blockIdx.x;
    const int vcu = (G % 8 == 0) ? (bx % 8) * (G / 8) + bx / 8 : bx;
    unsigned char* ws = p.ws;
    const float* MOD = (const float*)(ws + WS_MOD);
    typedef pg8::EpiBf16<0> EpiSt;
    volatile LAS unsigned* MISC = (volatile LAS unsigned*)(lds + 131072 + 512);
    if (threadIdx.x < 2) MISC[threadIdx.x] = 0u;
    __syncthreads();
    const XcdBarrier bar = xcd_barrier_post((unsigned*)(ws + WS_BAR), MISC);
#define IN(k) (p.lo <= (k) && (k) < p.hi)
#define SEAM(k) do { if (IN(k) && IN((k) + 1)) { if ((k) == 0) grid.sync(); else xcd_barrier(bar); } } while (0)
#define STORE_GEMM(Aoff, Woff, N_, K_, Ooff, ldc_, splitc, splits) do { \
        pg8::Gemm g{(const pg8::bf16_t*)(ws + (Aoff)), (const pg8::bf16_t*)(ws + (Woff)), MROWS, (N_), (K_)}; \
        EpiSt E{(pg8::bf16_t*)(ws + (Ooff)), (ldc_), nullptr, (splitc), (splits), 1.f}; \
        pg8::StaticOrder S; S.init(MROWS, (N_), G, bx); \
        pg8::gemm_phase<EpiSt, pg8::StaticOrder, true, true>(lds, g, S, E); } while (0)
#define RESID_GEMM(Aoff, Woff, K_, xin_, sub) do { \
        pg8::Gemm g{(const pg8::bf16_t*)(ws + (Aoff)), (const pg8::bf16_t*)(ws + (Woff)), MROWS, 1024, (K_)}; \
        EpiResid E{(xin_), p.out, MOD + (sub) * 4 * 3072 + 2048}; \
        pg8::StaticOrder S; S.init(MROWS, 1024, G, bx); \
        pg8::gemm_phase<EpiResid, pg8::StaticOrder, true, true>(lds, g, S, E); } while (0)
    if (IN(0)) p_prologue(p, lds);
    SEAM(0);
    if (IN(1)) p_modulate(p);
    SEAM(1);
    if (IN(2)) STORE_GEMM(WS_U, W_ABIN, 2048, 1024, WS_Y1, 2048, 0, 0);
    SEAM(2);
    if (IN(3)) p_norm3(p);
    SEAM(3);
    if (IN(4)) {
        STORE_GEMM(WS_CQN, W_UQ, 768, 256, WS_QA, 768, 0, 0);
        STORE_GEMM(WS_CKVN, W_UKV, 1024, 128, WS_KV, 1024, 0, 0);
    }
    SEAM(4);
    if (IN(5)) att::phase_ab(p, lds, vcu, G);
    SEAM(5);
    if (IN(6)) RESID_GEMM(WS_U, W_ABOUT, 1024, p.in[0], 0);
    SEAM(6);
    if (IN(7)) p_ln(p, 0, 1, false);
    SEAM(7);
    if (IN(8)) STORE_GEMM(WS_U, W_UP0, 2 * DFF, 1024, WS_G, DFF, DFF, (size_t)(WS_H - WS_G) / 2);
    SEAM(8);
    if (IN(9)) p_conv(p, 0);
    SEAM(9);
    if (IN(10)) RESID_GEMM(WS_H, W_DN0, DFF, p.out, 1);
    SEAM(10);
    if (IN(11)) p_ln(p, 1, 2, true);
    SEAM(11);
    if (IN(12)) { p_scan(p, lds); STORE_GEMM(WS_U, W_CDIN, 3072, 1024, WS_QKV1, 3072, 0, 0); }
    SEAM(12);
    if (IN(13)) att::phase_cd(p, lds, vcu, G);
    SEAM(13);
    if (IN(14)) RESID_GEMM(WS_MRG1, W_CDOUT, 1024, p.out, 2);
    SEAM(14);
    if (IN(15)) p_ln(p, 2, 3, false);
    SEAM(15);
    if (IN(16)) STORE_GEMM(WS_U, W_UP1, 2 * DFF, 1024, WS_G, DFF, DFF, (size_t)(WS_H - WS_G) / 2);
    SEAM(16);
    if (IN(17)) p_conv(p, 1);
    SEAM(17);
    if (IN(18)) RESID_GEMM(WS_H, W_DN1, DFF, p.out, 3);
    SEAM(18);
    if (IN(19)) p_ln(p, 3, -1, false);
}

extern "C" void kernel_launch(void* const* d_in, const int* in_sizes, int n_in, void* d_out, int out_size, void* d_ws, size_t ws_size, hipStream_t stream) {
    static int grid = 0;
    if (grid == 0) {
        if (n_in != 27 || out_size != MROWS * DM || ws_size < WS_END) { fprintf(stderr, "kernel_launch: unexpected shapes (n_in %d out %d ws %zu)\n", n_in, out_size, ws_size); grid = -1; return; }
        int dev = 0, cus = 0, per_cu = 0;
        (void)hipGetDevice(&dev); (void)hipDeviceGetAttribute(&cus, hipDeviceAttributeMultiprocessorCount, dev);
        if (hipFuncSetAttribute((const void*)mega_fwd, hipFuncAttributeMaxDynamicSharedMemorySize, LDS_BYTES) != hipSuccess) { fprintf(stderr, "kernel_launch: hipFuncSetAttribute failed\n"); grid = -1; return; }
        if (hipOccupancyMaxActiveBlocksPerMultiprocessor(&per_cu, (const void*)mega_fwd, NTHR, LDS_BYTES) != hipSuccess || per_cu < 1) { fprintf(stderr, "kernel_launch: occupancy query says %d\n", per_cu); per_cu = 1; }
        (void)hipGetLastError();
        grid = cus;
    }
    if (grid < 0) return;
    Params a{};
    for (int i = 0; i < 27; ++i) a.in[i] = (const float*)d_in[i];
    a.out = (float*)d_out; a.ws = (unsigned char*)d_ws; a.lo = 0; a.hi = NPHASE;
    if (hipMemsetAsync((char*)d_ws + WS_BAR, 0, 16384, stream) != hipSuccess) { fprintf(stderr, "kernel_launch: memset failed\n"); return; }
    void* args[] = {&a};
    hipError_t e = hipLaunchCooperativeKernel((const void*)mega_fwd, dim3(grid), dim3(NTHR), args, LDS_BYTES, stream);
    if (e != hipSuccess) fprintf(stderr, "cooperative launch failed: %s (grid %d)\n", hipGetErrorString(e), grid);
}
```

```cpp
#include <hip/hip_runtime.h>
#include <hip/hip_cooperative_groups.h>
#include <cstdio>
#include <cstdint>
namespace cg = cooperative_groups;
namespace pg8 {
#define PG8_LAS __attribute__((address_space(3)))
typedef unsigned short bf16_t;
typedef short bf16x8 __attribute__((ext_vector_type(8)));
typedef float f32x4 __attribute__((ext_vector_type(4)));
typedef unsigned u32x4 __attribute__((ext_vector_type(4)));
constexpr int BM = 256, BK = 64, HALF = 128, HTB = HALF * BK * 2  , STAGE_BYTES = 8 * HTB, NXCD = 8, WGM = 8;

__host__ __device__ __forceinline__ int lds_byte(int r, int c) { const int st = (r >> 4) * 2 + (c >> 5), rr = r & 15, cc = c & 31, ob = rr * 64 + cc * 2; return st * 1024 + (ob ^ (((ob >> 9) & 1) << 5)); }
__host__ __device__ __forceinline__ void stage_rc(int b, int& R, int& C) { const int st = b / 1024, sb = b % 1024, swz = sb ^ (((sb >> 9) & 1) << 5); R = (st >> 1) * 16 + swz / 64; C = (st & 1) * 32 + (swz % 64) / 2; }
__host__ __device__ __forceinline__ int perm32(int rho) { const int n = rho >> 4, i = rho & 15; return 8 * (i >> 2) + 4 * n + (i & 3); }

struct Unit { int pm, pn; };
struct Gemm { const bf16_t* A; const bf16_t* Bt; int M, N, K; };

struct StaticOrder {
    int nM, nN, nwg, G, c;
    __host__ __device__ void init(int M, int N, int G_, int c_) { nM = M / BM; nN = N / BM; nwg = nM * nN; G = G_; c = c_; }
    __host__ __device__ bool next(int i, Unit& u) const {
        const long L = (long)i * G + c; if (L >= nwg) return false;
        int wgid = (int)L; { const int q = nwg / NXCD, r = nwg % NXCD, xcd = wgid % NXCD, off = wgid / NXCD; wgid = (xcd < r ? xcd * (q + 1) : r * (q + 1) + (xcd - r) * q) + off; }
        const int nig = WGM * nN, gid = wgid / nig, fm = gid * WGM, gsz = (nM - fm) < WGM ? (nM - fm) : WGM;
        u.pm = fm + ((wgid % nig) % gsz); u.pn = (wgid % nig) / gsz; return true;
    }
    __device__ __forceinline__ void a_ready(const Unit&) const {}
    __device__ __forceinline__ void done(const Unit&) const {}
};

__device__ __forceinline__ unsigned cvt_pk_bf16(float lo, float hi) { unsigned r; asm volatile("v_cvt_pk_bf16_f32 %0, %1, %2" : "=v"(r) : "v"(lo), "v"(hi)); return r; }
typedef float f32x2 __attribute__((ext_vector_type(2)));
__device__ __forceinline__ f32x2 gelu_pk(f32x2 v) {
    const f32x2 av = __builtin_elementwise_abs(v), d = av * 0.2316418882f + 1.0f;
    f32x2 t; t.x = __builtin_amdgcn_rcpf(d.x); t.y = __builtin_amdgcn_rcpf(d.y);
    f32x2 q = t * 0.5307027145f + (-0.7265760135f); q = q * t + 0.7107068705f; q = q * t + (-0.142248368f); q = q * t + 0.127414796f; q = q * t;
    const f32x2 s = (v * v) * (-0.72134752044f);
    f32x2 e; e.x = __builtin_amdgcn_exp2f(s.x); e.y = __builtin_amdgcn_exp2f(s.y);
    const f32x2 m = v * (q * e), r = v - m;
    f32x2 o; o.x = v.x < 0.f ? m.x : r.x; o.y = v.y < 0.f ? m.y : r.y; return o;
}

template <int ACT  > struct EpiBf16 {
    static constexpr bool PERM = true, AFTER_DRAIN = false; static_assert(ACT == 0 || ACT == 1, "EpiBf16: ACT is 0 (none) or 1 (gelu_pk)");
    bf16_t* O; int ldc; const float* bias; int split_cols; size_t split_stride; float scale0;
    __device__ __forceinline__ void operator()(const f32x4 (&acc)[2][2][4][2], const Unit& u, int wr, int wc, int fr, int fq) const {
        const int row0 = u.pm * BM + wr * 64 + fr; int colt = u.pn * BM; bf16_t* base = O;
        float sc = 1.f; if (split_cols) { const int t = colt / split_cols; base += (size_t)t * split_stride; colt -= t * split_cols; if (t == 0) sc = scale0; }
        const int col0 = colt + wc * 32 + 8 * fq, bcol0 = u.pn * BM + wc * 32 + 8 * fq;
        f32x4 bv[2][2];
#pragma unroll
        for (int bj = 0; bj < 2; ++bj)
#pragma unroll
            for (int n = 0; n < 2; ++n) bv[bj][n] = bias ? *(const f32x4*)(bias + bcol0 + bj * HALF + 4 * n) : (f32x4){0.f, 0.f, 0.f, 0.f};
#pragma unroll
        for (int ai = 0; ai < 2; ++ai)
#pragma unroll
            for (int m = 0; m < 4; ++m) { bf16_t* rowp = base + (size_t)(row0 + ai * HALF + m * 16) * ldc + col0;
#pragma unroll
                for (int bj = 0; bj < 2; ++bj) { f32x4 v0 = acc[ai][bj][m][0] + bv[bj][0], v1 = acc[ai][bj][m][1] + bv[bj][1];
                    if (ACT == 1) { f32x2 a = gelu_pk((f32x2){v0[0], v0[1]}), b = gelu_pk((f32x2){v0[2], v0[3]}), c = gelu_pk((f32x2){v1[0], v1[1]}), d = gelu_pk((f32x2){v1[2], v1[3]});
                        v0 = (f32x4){a.x, a.y, b.x, b.y}; v1 = (f32x4){c.x, c.y, d.x, d.y}; }
                    v0 = v0 * sc; v1 = v1 * sc; u32x4 w; w.x = cvt_pk_bf16(v0[0], v0[1]); w.y = cvt_pk_bf16(v0[2], v0[3]); w.z = cvt_pk_bf16(v1[0], v1[1]); w.w = cvt_pk_bf16(v1[2], v1[3]);
                    *(u32x4*)(rowp + bj * HALF) = w; } }
    }
};

struct PanelStats {
    unsigned* xbuf;
    unsigned* cnt;
    unsigned* tmo;
    int ntn; float eps;
    unsigned code;
    __device__ __forceinline__ bool run(const f32x4 (&v)[2][2][4][2], const Unit& u, int wr, int wc, int fr, int fq, PG8_LAS unsigned char* lds, int wid, int lane) const {
        typedef float f32x2v __attribute__((ext_vector_type(2)));
        PG8_LAS f32x2v* P = (PG8_LAS f32x2v*)lds;
        PG8_LAS f32x2v* S = (PG8_LAS f32x2v*)(lds + 8192);
        PG8_LAS unsigned* flag = (PG8_LAS unsigned*)(lds + 8192 + 2048);
#pragma unroll
        for (int ai = 0; ai < 2; ++ai)
#pragma unroll
            for (int m = 0; m < 4; ++m) {
                float s = 0.f;
#pragma unroll
                for (int bj = 0; bj < 2; ++bj)
#pragma unroll
                    for (int n = 0; n < 2; ++n) { const f32x4 x = v[ai][bj][m][n]; s += (x[0] + x[1]) + (x[2] + x[3]); }
                s += __shfl_xor(s, 16); s += __shfl_xor(s, 32);
                const float mw = s * (1.0f / 64.0f); float q = 0.f;
#pragma unroll
                for (int bj = 0; bj < 2; ++bj)
#pragma unroll
                    for (int n = 0; n < 2; ++n) { const f32x4 d = v[ai][bj][m][n] - mw; q += (d[0] * d[0] + d[1] * d[1]) + (d[2] * d[2] + d[3] * d[3]); }
                q += __shfl_xor(q, 16); q += __shfl_xor(q, 32);
                if (fq == 0) P[(ai * HALF + wr * 64 + m * 16 + fr) * 4 + wc] = (f32x2v){mw, q};
            }
        asm volatile("s_waitcnt lgkmcnt(0)" ::: "memory"); __builtin_amdgcn_s_barrier(); asm volatile("" ::: "memory");
#if defined(BROKEN_EXCHANGE_NO_WAIT)
#warning BROKEN CONTROL BUILD: the row-statistics exchange does not wait; results are wrong by design
        if (blockIdx.x >= 64) { const long long t0_ = clock64(); while (clock64() - t0_ < 60000) __builtin_amdgcn_s_sleep(8); }
#endif
        const int row = wid * 32 + (lane & 31);
        if (lane < 32) {
            const f32x2v a = P[row * 4 + 0], b = P[row * 4 + 1], c = P[row * 4 + 2], d = P[row * 4 + 3];
            const float mt = (a.x + b.x + c.x + d.x) * 0.25f;
            const float da = a.x - mt, db = b.x - mt, dc = c.x - mt, dd = d.x - mt;
            const float m2 = (a.y + b.y) + (c.y + d.y) + 64.0f * ((da * da + db * db) + (dc * dc + dd * dd));
            unsigned long long* slot = (unsigned long long*)xbuf + ((size_t)(u.pm * BM + row) * 4 + u.pn);
            __hip_atomic_store(slot, ((unsigned long long)__float_as_uint(m2) << 32) | __float_as_uint(mt), __ATOMIC_RELAXED, __HIP_MEMORY_SCOPE_AGENT);
        }
        asm volatile("s_waitcnt vmcnt(0)" ::: "memory");
        if (lane == 0) __hip_atomic_fetch_add(cnt + 64 * u.pm, 1u, __ATOMIC_RELAXED, __HIP_MEMORY_SCOPE_AGENT);
        if (wid == 0) {
            bool dead = false; const unsigned long long t0 = __builtin_amdgcn_s_memrealtime(); const unsigned want = 8u * (unsigned)ntn;
            for (;;) {
#if defined(BROKEN_EXCHANGE_NO_WAIT)
                break;
#endif
                if ((unsigned)__builtin_amdgcn_readfirstlane(__hip_atomic_load(cnt + 64 * u.pm, __ATOMIC_RELAXED, __HIP_MEMORY_SCOPE_AGENT)) >= want) break;
                if (__builtin_amdgcn_s_memrealtime() - t0 > 2000000ull) {
                    if (lane == 0) { unsigned expect = 0u; __hip_atomic_compare_exchange_strong(tmo + 1, &expect, code | (unsigned)(u.pm & 0xff), __ATOMIC_RELAXED, __ATOMIC_RELAXED, __HIP_MEMORY_SCOPE_AGENT);
                                     __hip_atomic_store(tmo, 1u, __ATOMIC_RELAXED, __HIP_MEMORY_SCOPE_AGENT); }
                    dead = true; break; }
                __builtin_amdgcn_s_sleep(2);
            }
            __builtin_amdgcn_fence(__ATOMIC_ACQUIRE, "agent");
            if (lane == 0) flag[0] = dead ? 1u : 0u;
        }
        asm volatile("s_waitcnt vmcnt(0) lgkmcnt(0)" ::: "memory"); __builtin_amdgcn_s_barrier(); asm volatile("" ::: "memory");
        const bool bad = flag[0] != 0u;
        if (lane < 32) {
            const unsigned long long* slot = (const unsigned long long*)xbuf + (size_t)(u.pm * BM + row) * 4; float mt[4], m2[4]; float ms = 0.f;
#pragma unroll
            for (int t = 0; t < 4; ++t) { if (t < ntn) { const unsigned long long w = __hip_atomic_load(slot + t, __ATOMIC_RELAXED, __HIP_MEMORY_SCOPE_AGENT); mt[t] = __uint_as_float((unsigned)w); m2[t] = __uint_as_float((unsigned)(w >> 32)); } else { mt[t] = 0.f; m2[t] = 0.f; } ms += mt[t]; }
            const float mean = ms / (float)ntn; float q = 0.f;
#pragma unroll
            for (int t = 0; t < 4; ++t) if (t < ntn) { const float dm = mt[t] - mean; q += m2[t] + 256.0f * dm * dm; }
            S[row] = (f32x2v){mean, 1.0f / sqrtf(q / (256.0f * (float)ntn) + eps)};
        }
        asm volatile("s_waitcnt lgkmcnt(0)" ::: "memory"); __builtin_amdgcn_s_barrier(); asm volatile("" ::: "memory");
        return bad;
    }
};
struct EpiLnRes {
    static constexpr bool PERM = false, AFTER_DRAIN = true;
    const float* base; float* out; int ldc; const float* bias; PanelStats st; unsigned poison;
    __device__ __forceinline__ void fused(f32x4 (&acc)[2][2][4][2], const Unit& u, int wr, int wc, int fr, int fq, PG8_LAS unsigned char* lds, int wid, int lane) const {
        typedef float f32x2v __attribute__((ext_vector_type(2)));
        const PG8_LAS f32x2v* S = (const PG8_LAS f32x2v*)(lds + 8192);
        const int col0 = u.pn * BM + wc * 32 + 4 * fq;
#pragma unroll
        for (int bj = 0; bj < 2; ++bj)
#pragma unroll
            for (int n = 0; n < 2; ++n) { const f32x4 bv = bias ? *(const f32x4*)(bias + col0 + bj * HALF + n * 16) : (f32x4){0.f, 0.f, 0.f, 0.f};
#pragma unroll
                for (int ai = 0; ai < 2; ++ai)
#pragma unroll
                    for (int m = 0; m < 4; ++m) acc[ai][bj][m][n] += bv; }
        f32x4 pre[4][2][2];
#pragma unroll
        for (int m = 0; m < 4; ++m) { const size_t off = (size_t)(u.pm * BM + wr * 64 + m * 16 + fr) * ldc + col0;
#pragma unroll
            for (int bj = 0; bj < 2; ++bj)
#pragma unroll
                for (int n = 0; n < 2; ++n) pre[m][bj][n] = *(const f32x4*)(base + off + bj * HALF + n * 16); }
        const bool bad = st.run(acc, u, wr, wc, fr, fq, lds, wid, lane) || poison != 0u;
        const float qnan = __builtin_nanf("");
#pragma unroll
        for (int ai = 0; ai < 2; ++ai)
#pragma unroll
            for (int m = 0; m < 4; ++m) { const int r = ai * HALF + wr * 64 + m * 16 + fr; const f32x2v sr = S[r]; const size_t off = (size_t)(u.pm * BM + r) * ldc + col0;
#pragma unroll
                for (int bj = 0; bj < 2; ++bj)
#pragma unroll
                    for (int n = 0; n < 2; ++n) { const f32x4 bs = ai == 0 ? pre[m][bj][n] : *(const f32x4*)(base + off + bj * HALF + n * 16); f32x4 o = bs + (acc[ai][bj][m][n] - sr.x) * sr.y;
                        if (bad) o = (f32x4){qnan, qnan, qnan, qnan}; *(f32x4*)(out + off + bj * HALF + n * 16) = o; }
                if (m & 1) asm volatile("" ::: "memory"); }
    }
};
struct EpiLnResLn {
    static constexpr bool PERM = false, AFTER_DRAIN = true;
    const float* base; float* out; bf16_t* xn; int ldc; const float* bias; PanelStats st1, st2; unsigned poison;
    __device__ __forceinline__ void fused(f32x4 (&acc)[2][2][4][2], const Unit& u, int wr, int wc, int fr, int fq, PG8_LAS unsigned char* lds, int wid, int lane) const {
        typedef float f32x2v __attribute__((ext_vector_type(2))); typedef unsigned u32x2v __attribute__((ext_vector_type(2)));
        const PG8_LAS f32x2v* S = (const PG8_LAS f32x2v*)(lds + 8192);
        const int col0 = u.pn * BM + wc * 32 + 4 * fq;
#pragma unroll
        for (int bj = 0; bj < 2; ++bj)
#pragma unroll
            for (int n = 0; n < 2; ++n) { const f32x4 bv = bias ? *(const f32x4*)(bias + col0 + bj * HALF + n * 16) : (f32x4){0.f, 0.f, 0.f, 0.f};
#pragma unroll
                for (int ai = 0; ai < 2; ++ai)
#pragma unroll
                    for (int m = 0; m < 4; ++m) acc[ai][bj][m][n] += bv; }
        bool bad = st1.run(acc, u, wr, wc, fr, fq, lds, wid, lane) || poison != 0u;
        const float qnan = __builtin_nanf("");
#pragma unroll
        for (int ai = 0; ai < 2; ++ai)
#pragma unroll
            for (int m = 0; m < 4; ++m) { const int r = ai * HALF + wr * 64 + m * 16 + fr; const f32x2v sr = S[r]; const size_t off = (size_t)(u.pm * BM + r) * ldc + col0;
#pragma unroll
                for (int bj = 0; bj < 2; ++bj)
#pragma unroll
                    for (int n = 0; n < 2; ++n) { const f32x4 bs = *(const f32x4*)(base + off + bj * HALF + n * 16); acc[ai][bj][m][n] = bs + (acc[ai][bj][m][n] - sr.x) * sr.y; }
                asm volatile("" : "+v"(acc[ai][0][m][0]), "+v"(acc[ai][0][m][1]), "+v"(acc[ai][1][m][0]), "+v"(acc[ai][1][m][1]));
                if (m & 1) asm volatile("" ::: "memory"); }
        const bool bad1 = bad;
        bad = st2.run(acc, u, wr, wc, fr, fq, lds, wid, lane) || bad;
#pragma unroll
        for (int ai = 0; ai < 2; ++ai)
#pragma unroll
            for (int m = 0; m < 4; ++m) { const int r = ai * HALF + wr * 64 + m * 16 + fr; const f32x2v sr = S[r]; const size_t off = (size_t)(u.pm * BM + r) * ldc + col0;
#pragma unroll
                for (int bj = 0; bj < 2; ++bj)
#pragma unroll
                    for (int n = 0; n < 2; ++n) { const f32x4 x1 = acc[ai][bj][m][n]; *(f32x4*)(out + off + bj * HALF + n * 16) = bad1 ? (f32x4){qnan, qnan, qnan, qnan} : x1;
                        const f32x4 o = (x1 - sr.x) * sr.y; u32x2v w; w.x = cvt_pk_bf16(o[0], o[1]); w.y = cvt_pk_bf16(o[2], o[3]);
                        if (bad) { w.x = 0x7fc07fc0u; w.y = 0x7fc07fc0u; } *(u32x2v*)(xn + off + bj * HALF + n * 16) = w; }
                asm volatile("" ::: "memory"); }
    }
};

template <class Epi, class Sched, bool ALIGN_EPI = false, bool SP2 = false>
__device__ __forceinline__ void gemm_phase(PG8_LAS unsigned char* lds, const Gemm g, const Sched& S, const Epi& E) {
    const int tid = threadIdx.x, wid = __builtin_amdgcn_readfirstlane(tid >> 6), lane = tid & 63, wr = wid >> 2, wc = wid & 3, fr = lane & 15, fq = lane >> 4;
    const int K = g.K, nt = K / BK;
    unsigned voffA[2], voffB[2];
#pragma unroll
    for (int i = 0; i < 2; ++i) { int R, C; stage_rc(tid * 16 + i * 8192, R, C); const int Rb = Epi::PERM ? ((R & ~31) + perm32(R & 31)) : R;
        voffA[i] = (unsigned)(R * K + C) * 2u; voffB[i] = (unsigned)(Rb * K + C) * 2u; }
    const size_t kstep = (size_t)(BK * 2);
    const size_t hstep = (size_t)HALF * K * 2;
    const size_t tstep = 2 * hstep;
    const unsigned ldsw = (unsigned)wid * 1024u;
    const int aoff = lds_byte(wr * 64 + fr, fq * 8), boff = lds_byte(wc * 32 + fr, fq * 8);
#define PG8_SA(b, h) (((b) * 2 + (h)) * HTB)
#define PG8_SB(b, h) ((4 + (b) * 2 + (h)) * HTB)
#define PG8_STAGE(bufoff, gbase, voff) do { _Pragma("unroll") for (int _i = 0; _i < 2; ++_i) \
        __builtin_amdgcn_global_load_lds((const unsigned*)((const char*)(gbase) + (voff)[_i]), (PG8_LAS unsigned*)(lds + (bufoff) + ldsw + _i * 8192), 16, 0, 0); } while (0)
#define PG8_LDA(dst, b, h) do { _Pragma("unroll") for (int m = 0; m < 4; ++m) _Pragma("unroll") for (int k = 0; k < 2; ++k) dst[m][k] = *(const PG8_LAS bf16x8*)(lds + PG8_SA(b, h) + aoff + m * 2048 + k * 1024); } while (0)
#define PG8_LDB(dst, b, h) do { _Pragma("unroll") for (int n = 0; n < 2; ++n) _Pragma("unroll") for (int k = 0; k < 2; ++k) dst[n][k] = *(const PG8_LAS bf16x8*)(lds + PG8_SB(b, h) + boff + n * 2048 + k * 1024); } while (0)
#define PG8_MMA(ai, bj, At, Bt) do { __builtin_amdgcn_s_setprio(1); _Pragma("unroll") for (int m = 0; m < 4; ++m) _Pragma("unroll") for (int n = 0; n < 2; ++n) _Pragma("unroll") for (int k = 0; k < 2; ++k) \
        acc[ai][bj][m][n] = __builtin_amdgcn_mfma_f32_16x16x32_bf16(Bt[n][k], At[m][k], acc[ai][bj][m][n], 0, 0, 0); __builtin_amdgcn_s_setprio(0); } while (0)
#define PG8_WAIT_V(n) asm volatile("s_waitcnt vmcnt(" #n ")" ::: "memory")
#define PG8_WAIT_L(n) asm volatile("s_waitcnt lgkmcnt(" #n ")" ::: "memory")
#define PG8_BAR __builtin_amdgcn_s_barrier()
#define PG8_SCHED __builtin_amdgcn_sched_barrier(0)
    Unit cur, nxt; int ui = 0;
    if (!S.next(0, cur)) return;
    f32x4 acc[2][2][4][2];
#pragma unroll
    for (int a = 0; a < 2; ++a)
#pragma unroll
        for (int b = 0; b < 2; ++b)
#pragma unroll
            for (int m = 0; m < 4; ++m)
#pragma unroll
                for (int n = 0; n < 2; ++n) acc[a][b][m][n] = (f32x4){0.f, 0.f, 0.f, 0.f};
    bf16x8 At[4][2], B0[2][2], B1[2][2];
    const char* cA = (const char*)g.A + (size_t)cur.pm * tstep; const char* cB = (const char*)g.Bt + (size_t)cur.pn * tstep;
    S.a_ready(cur);
    if constexpr (SP2) {
        PG8_STAGE(PG8_SB(0, 0), cB, voffB); PG8_STAGE(PG8_SB(0, 1), cB + hstep, voffB); PG8_STAGE(PG8_SA(0, 0), cA, voffA); PG8_STAGE(PG8_SA(0, 1), cA + hstep, voffA);
        if (wr == 1) PG8_BAR;
        PG8_WAIT_V(2); PG8_BAR;
        PG8_STAGE(PG8_SB(1, 0), cB + kstep, voffB); PG8_STAGE(PG8_SA(1, 0), cA + kstep, voffA); PG8_STAGE(PG8_SB(1, 1), cB + hstep + kstep, voffB);
        PG8_WAIT_V(6); PG8_BAR;
    } else {
        PG8_STAGE(PG8_SB(0, 0), cB, voffB); PG8_STAGE(PG8_SA(0, 0), cA, voffA); PG8_STAGE(PG8_SB(0, 1), cB + hstep, voffB); PG8_STAGE(PG8_SA(0, 1), cA + hstep, voffA);
        if (wr == 1) PG8_BAR;
        PG8_WAIT_V(4); PG8_BAR;
        PG8_STAGE(PG8_SB(1, 0), cB + kstep, voffB); PG8_STAGE(PG8_SA(1, 0), cA + kstep, voffA); PG8_STAGE(PG8_SB(1, 1), cB + hstep + kstep, voffB);
        PG8_WAIT_V(6); PG8_BAR;
    }
    for (;;) {
        const bool has_next = S.next(ui + 1, nxt);
        const char* nA = has_next ? (const char*)g.A + (size_t)nxt.pm * tstep : cA; const char* nB = has_next ? (const char*)g.Bt + (size_t)nxt.pn * tstep : cB;
        for (int t = 0; t < nt; t += 2) {
            const bool last = (t == nt - 2);
            const char* a1 = cA + (size_t)(t + 1) * kstep;
            const char* a2 = last ? nA : cA + (size_t)(t + 2) * kstep; const char* b2 = last ? nB : cB + (size_t)(t + 2) * kstep;
            const char* a3 = a2 + kstep; const char* b3 = b2 + kstep;
            if (last && has_next) S.a_ready(nxt);
            if constexpr (SP2) {
            PG8_LDB(B0, 0, 0); PG8_LDB(B1, 0, 1); PG8_SCHED; PG8_LDA(At, 0, 0); PG8_STAGE(PG8_SA(1, 1), a1 + hstep, voffA);
            PG8_WAIT_V(8); PG8_WAIT_L(0); PG8_BAR; PG8_MMA(0, 0, At, B0); PG8_MMA(0, 1, At, B1); PG8_BAR; PG8_SCHED;
            PG8_LDA(At, 0, 1); PG8_STAGE(PG8_SB(0, 0), b2, voffB); PG8_STAGE(PG8_SB(0, 1), b2 + hstep, voffB); PG8_STAGE(PG8_SA(0, 0), a2, voffA);
            PG8_WAIT_V(8); PG8_WAIT_L(0); PG8_BAR; PG8_MMA(1, 0, At, B0); PG8_MMA(1, 1, At, B1); PG8_BAR; PG8_SCHED;
            PG8_LDB(B0, 1, 0); PG8_LDB(B1, 1, 1); PG8_SCHED; PG8_LDA(At, 1, 0); PG8_STAGE(PG8_SA(0, 1), a2 + hstep, voffA);
            PG8_WAIT_V(8); PG8_WAIT_L(0); PG8_BAR; PG8_MMA(0, 0, At, B0); PG8_MMA(0, 1, At, B1); PG8_BAR; PG8_SCHED;
            PG8_LDA(At, 1, 1); PG8_STAGE(PG8_SB(1, 0), b3, voffB); PG8_STAGE(PG8_SB(1, 1), b3 + hstep, voffB); PG8_STAGE(PG8_SA(1, 0), a3, voffA);
            PG8_WAIT_V(8); PG8_WAIT_L(0); PG8_BAR; PG8_MMA(1, 0, At, B0); PG8_MMA(1, 1, At, B1); PG8_BAR; PG8_SCHED;
            } else {
            PG8_LDB(B0, 0, 0); PG8_SCHED; PG8_LDA(At, 0, 0); PG8_STAGE(PG8_SA(1, 1), a1 + hstep, voffA);
            PG8_WAIT_L(8); PG8_BAR; PG8_WAIT_L(0); PG8_MMA(0, 0, At, B0); PG8_BAR; PG8_SCHED;
            PG8_LDB(B1, 0, 1); PG8_STAGE(PG8_SB(0, 0), b2, voffB);
            PG8_BAR; PG8_WAIT_L(0); PG8_MMA(0, 1, At, B1); PG8_BAR;
            PG8_LDA(At, 0, 1); PG8_STAGE(PG8_SA(0, 0), a2, voffA);
            PG8_BAR; PG8_WAIT_L(0); PG8_MMA(1, 0, At, B0); PG8_BAR; PG8_SCHED;
            PG8_STAGE(PG8_SB(0, 1), b2 + hstep, voffB);
            PG8_WAIT_V(6); PG8_BAR; PG8_MMA(1, 1, At, B1); PG8_BAR;
            PG8_LDB(B0, 1, 0); PG8_SCHED; PG8_LDA(At, 1, 0); PG8_STAGE(PG8_SA(0, 1), a2 + hstep, voffA);
            PG8_WAIT_L(8); PG8_BAR; PG8_WAIT_L(0); PG8_MMA(0, 0, At, B0); PG8_BAR; PG8_SCHED;
            PG8_LDB(B1, 1, 1); PG8_STAGE(PG8_SB(1, 0), b3, voffB);
            PG8_BAR; PG8_WAIT_L(0); PG8_MMA(0, 1, At, B1); PG8_BAR;
            PG8_LDA(At, 1, 1); PG8_STAGE(PG8_SA(1, 0), a3, voffA);
            PG8_BAR; PG8_WAIT_L(0); PG8_MMA(1, 0, At, B0); PG8_BAR; PG8_SCHED;
            PG8_STAGE(PG8_SB(1, 1), b3 + hstep, voffB);
            PG8_WAIT_V(6); PG8_BAR; PG8_MMA(1, 1, At, B1); PG8_BAR;
            }
        }
        if constexpr (ALIGN_EPI) { if (wr == 0) PG8_BAR; }
        if constexpr (!Epi::AFTER_DRAIN) { E(acc, cur, wr, wc, fr, fq); S.done(cur); }
        if (!has_next) break;
#pragma unroll
        for (int a = 0; a < 2; ++a)
#pragma unroll
            for (int b = 0; b < 2; ++b)
#pragma unroll
                for (int m = 0; m < 4; ++m)
#pragma unroll
                    for (int n = 0; n < 2; ++n) acc[a][b][m][n] = (f32x4){0.f, 0.f, 0.f, 0.f};
        cur = nxt; cA = nA; cB = nB; ++ui;
        if constexpr (ALIGN_EPI) { if (wr == 1) PG8_BAR; }
    }
    PG8_WAIT_V(0);
    if constexpr (!ALIGN_EPI) { if (wr == 0) PG8_BAR; }
    PG8_BAR;
    if constexpr (Epi::AFTER_DRAIN) { E.fused(acc, cur, wr, wc, fr, fq, lds, wid, lane); S.done(cur); }
#undef PG8_SA
#undef PG8_SB
#undef PG8_STAGE
#undef PG8_LDA
#undef PG8_LDB
#undef PG8_MMA
#undef PG8_WAIT_V
#undef PG8_WAIT_L
#undef PG8_BAR
#undef PG8_SCHED
}
}

#define LAS __attribute__((address_space(3)))
typedef unsigned short bf16;
typedef unsigned u32x4 __attribute__((ext_vector_type(4)));
typedef unsigned u32x2 __attribute__((ext_vector_type(2)));
typedef float f32x4 __attribute__((ext_vector_type(4)));
typedef float f32x2 __attribute__((ext_vector_type(2)));
typedef float f32x16 __attribute__((ext_vector_type(16)));
typedef short bf16x8 __attribute__((ext_vector_type(8)));
typedef short s16x4 __attribute__((ext_vector_type(4)));
typedef __bf16 bf16x2_t __attribute__((ext_vector_type(2)));
#define DI __device__ __forceinline__

DI unsigned pk2(float lo, float hi) { f32x2 v = {lo, hi}; bf16x2_t b = __builtin_convertvector(v, bf16x2_t); return __builtin_bit_cast(unsigned, b); }
DI float bflo(unsigned u) { return __uint_as_float(u << 16); }
DI float bfhi(unsigned u) { return __uint_as_float(u & 0xffff0000u); }
DI float wave_sum(float v) {
#pragma unroll
    for (int o = 1; o < 64; o <<= 1) v += __shfl_xor(v, o);
    return v;
}

constexpr int NB = 4, SEQ = 8192, DM = 1024, MROWS = NB * SEQ, DFF = 2816;
constexpr float LOG2E = 1.4426950408889634f;
constexpr float SC_A = 0.14724444602590306f;
constexpr float SC_64 = 0.18033688011112042f;
constexpr float ALPHA = 1.4142135623730951f;
constexpr int NWAVES = 8, NTHR = 512;
constexpr int LDS_BYTES = 147456;

constexpr size_t MiB = 1u << 20;
constexpr size_t WS_MOD = 0;
constexpr size_t WS_MISC = 256 * 1024;
constexpr size_t WS_BAR = 512 * 1024;
constexpr size_t WS_ROPE = 1 * MiB;
constexpr size_t WS_LF = 2 * MiB;
constexpr size_t WS_F = 3 * MiB;
constexpr size_t W_ABIN = 8 * MiB, W_UQ = 12 * MiB, W_UKV = 12 * MiB + 512 * 1024, W_ABOUT = 13 * MiB, W_CDIN = 15 * MiB, W_CDOUT = 21 * MiB;
constexpr size_t W_UP0 = 23 * MiB, W_UP1 = 34 * MiB, W_DN0 = 45 * MiB, W_DN1 = 51 * MiB;
constexpr size_t WS_U = 64 * MiB;
constexpr size_t WS_R1 = 128 * MiB, WS_R2 = 304 * MiB;
constexpr size_t WS_Y1 = WS_R1;
constexpr size_t WS_QA = 256 * MiB;
constexpr size_t WS_KV = 304 * MiB;
constexpr size_t WS_CQN = 368 * MiB, WS_CKVN = 384 * MiB, WS_KROPE = 392 * MiB;
constexpr size_t WS_G = WS_R1, WS_H = WS_R2;
constexpr size_t WS_QKV1 = WS_R1;
constexpr size_t WS_MRG1 = 320 * MiB;
constexpr size_t WS_END = 480 * MiB;

struct Params { const float* in[27]; float* out; unsigned char* ws; int lo, hi; };

__constant__ float INVF[16] = {1.0f, 0.5623413324356079f, 0.3162277638912201f, 0.17782793939113617f, 0.10000000149011612f, 0.05623413249850273f, 0.03162277489900589f,
    0.017782794311642647f, 0.009999999776482582f, 0.005623413249850273f, 0.003162277629598975f, 0.0017782794311642647f, 0.0010000000474974513f, 0.000562341301701963f,
    0.0003162277571391314f, 0.00017782794020604342f};

DI void tr_item(const float* W, int K, int Nsrc, int srccol0, bf16* WT, int n0, int k0, float sc, LAS float* scr, int lane) {
#pragma unroll 8
    for (int i = 0; i < 32; ++i) { const int kk = 2 * i + (lane >> 5);
        const float v = (srccol0 >= 0) ? W[(size_t)(k0 + kk) * Nsrc + srccol0 + (lane & 31)] : 0.f; scr[kk * 33 + (lane & 31)] = v * sc; }
    asm volatile("s_waitcnt lgkmcnt(0)" ::: "memory");
    const int c = lane & 7;
#pragma unroll
    for (int j = 0; j < 4; ++j) { const int n = (lane >> 3) + 8 * j; const LAS float* s = scr + (8 * c) * 33 + n;
        u32x4 o; o.x = pk2(s[0 * 33], s[1 * 33]); o.y = pk2(s[2 * 33], s[3 * 33]); o.z = pk2(s[4 * 33], s[5 * 33]); o.w = pk2(s[6 * 33], s[7 * 33]);
        *(u32x4*)(WT + (size_t)(n0 + n) * K + k0 + 8 * c) = o; }
    asm volatile("s_waitcnt lgkmcnt(0)" ::: "memory");
}

DI void p_prologue(const Params& p, LAS unsigned char* lds) {
    const int tid = threadIdx.x, lane = tid & 63, wave = tid >> 6, G = gridDim.x, bx = blockIdx.x;
    const float* c = p.in[1]; const float* ada_w = p.in[2]; const float* ada_b = p.in[3];
    float* MOD = (float*)(p.ws + WS_MOD);
    LAS float* cond = (LAS float*)lds;
    LAS float* red = (LAS float*)(lds + 16384);
    for (int i = tid; i < 4096; i += NTHR) { const float v = c[i]; cond[i] = v / (1.f + __expf(-v)); }
    __syncthreads();
    for (int it = bx; it < 192; it += G) {
        const int sub = it / 48, cb = it % 48, col = cb * 64 + lane;
        const float* w = ada_w + (size_t)sub * 1024 * 3072 + col;
        float a0 = 0.f, a1 = 0.f, a2 = 0.f, a3 = 0.f; const int kb = wave * 128;
#pragma unroll 8
        for (int k = 0; k < 128; ++k) { const float wv = w[(size_t)(kb + k) * 3072];
            a0 += cond[kb + k] * wv; a1 += cond[1024 + kb + k] * wv; a2 += cond[2048 + kb + k] * wv; a3 += cond[3072 + kb + k] * wv; }
        red[(wave * 4 + 0) * 64 + lane] = a0; red[(wave * 4 + 1) * 64 + lane] = a1; red[(wave * 4 + 2) * 64 + lane] = a2; red[(wave * 4 + 3) * 64 + lane] = a3;
        __syncthreads();
        if (tid < 256) { const int b = tid >> 6; float s = 0.f;
#pragma unroll
            for (int w8 = 0; w8 < 8; ++w8) s += red[(w8 * 4 + b) * 64 + lane];
            s += ada_b[sub * 3072 + col]; if (col >= 1024) s += 1.f;
            MOD[(sub * 4 + b) * 3072 + col] = s; }
        __syncthreads();
    }
    LAS float* scr = (LAS float*)(lds + 32768 + wave * 8448);
    const int gw = bx * NWAVES + wave, NGW = G * NWAVES;
    constexpr int NITEMS = 1024 + 96 + 64 + 512 + 1536 + 512 + 4 * 1408 + 2 * 1408;
    for (int it = gw; it < NITEMS; it += NGW) {
        int r = it; int job = 0;
        const int cnt[12] = {1024, 96, 64, 512, 1536, 512, 1408, 1408, 1408, 1408, 1408, 1408};
#pragma unroll
        for (int j = 0; j < 11; ++j) { if (job == j && r >= cnt[j]) { r -= cnt[j]; job = j + 1; } }
        const float* W; int K, Nsrc, Ndst; bf16* WT;
        switch (job) {
            case 0: W = p.in[7]; K = 1024; Nsrc = 1952; Ndst = 2048; WT = (bf16*)(p.ws + W_ABIN); break;
            case 1: W = p.in[9]; K = 256; Nsrc = 768; Ndst = 768; WT = (bf16*)(p.ws + W_UQ); break;
            case 2: W = p.in[11]; K = 128; Nsrc = 1024; Ndst = 1024; WT = (bf16*)(p.ws + W_UKV); break;
            case 3: W = p.in[17]; K = 1024; Nsrc = 1024; Ndst = 1024; WT = (bf16*)(p.ws + W_ABOUT); break;
            case 4: W = p.in[18]; K = 1024; Nsrc = 3080; Ndst = 3072; WT = (bf16*)(p.ws + W_CDIN); break;
            case 5: W = p.in[21]; K = 1024; Nsrc = 1024; Ndst = 1024; WT = (bf16*)(p.ws + W_CDOUT); break;
            case 6: W = p.in[22]; K = 1024; Nsrc = 2816; Ndst = 2816; WT = (bf16*)(p.ws + W_UP0); break;
            case 7: W = p.in[23]; K = 1024; Nsrc = 2816; Ndst = 2816; WT = (bf16*)(p.ws + W_UP0) + (size_t)2816 * 1024; break;
            case 8: W = p.in[22] + (size_t)1024 * 2816; K = 1024; Nsrc = 2816; Ndst = 2816; WT = (bf16*)(p.ws + W_UP1); break;
            case 9: W = p.in[23] + (size_t)1024 * 2816; K = 1024; Nsrc = 2816; Ndst = 2816; WT = (bf16*)(p.ws + W_UP1) + (size_t)2816 * 1024; break;
            case 10: W = p.in[26]; K = 2816; Nsrc = 1024; Ndst = 1024; WT = (bf16*)(p.ws + W_DN0); break;
            default: W = p.in[26] + (size_t)2816 * 1024; K = 2816; Nsrc = 1024; Ndst = 1024; WT = (bf16*)(p.ws + W_DN1); break;
        }
        const int nblk = Ndst / 32, kb = r / nblk, nb = r % nblk, n0 = nb * 32, k0 = kb * 64;
        int src = n0; float sc = 1.f;
        if (job == 0) { src = (n0 < 1952) ? n0 : -1; if (n0 >= 416 && n0 < 928) sc = SC_64; }
        else if (job == 1) { src = (n0 < 512) ? (n0 >> 6) * 96 + (n0 & 63) : ((n0 - 512) >> 5) * 96 + 64; sc = SC_A; }
        else if (job == 2) { src = (n0 < 512) ? (n0 >> 6) * 128 + (n0 & 63) : ((n0 - 512) >> 6) * 128 + 64 + ((n0 - 512) & 63); }
        else if (job == 4) { src = (n0 < 1536) ? n0 : n0 + 8; if (n0 < 512 || (n0 >= 1536 && n0 < 2048)) sc = SC_64; }
        tr_item(W, K, Nsrc, src, WT, n0, k0, sc, scr, lane);
    }
    float* ROPE = (float*)(p.ws + WS_ROPE);
    for (int i = bx * NTHR + tid; i < SEQ * 16; i += G * NTHR) {
        const int pos = i >> 4, fi = i & 15;
        const float ang = (float)pos * INVF[fi];
        const double a = (double)ang, TWO_PI = 6.283185307179586476925;
        const double n = __builtin_rint(a * (1.0 / TWO_PI));
        const double x = a - n * TWO_PI, x2 = x * x;
        double sn = 1.0, cs = 1.0;
#pragma unroll
        for (int k = 13; k >= 1; --k) { sn = 1.0 - sn * x2 / (double)((2 * k) * (2 * k + 1)); cs = 1.0 - cs * x2 / (double)((2 * k - 1) * (2 * k)); }
        ROPE[i] = (float)cs; ROPE[SEQ * 16 + i] = (float)(sn * x);
    }
    if (bx == 0 && tid == 0) {
        float d1 = 0.f, d2 = 0.f;
        for (int i = 0; i < 64; ++i) { d1 += p.in[12][i] * p.in[13][i]; d2 += p.in[14][i] * p.in[15][i]; }
        ((float*)(p.ws + WS_MISC))[0] = expf(d1) - expf(d2) + 0.2f;
    }
}

DI void p_modulate(const Params& p) {
    const int tid = threadIdx.x, lane = tid & 63, wave = tid >> 6;
    const int gw = blockIdx.x * NWAVES + wave, NGW = gridDim.x * NWAVES;
    const float* x = p.in[0]; const float* MOD = (const float*)(p.ws + WS_MOD); bf16* U = (bf16*)(p.ws + WS_U);
    for (int row = gw; row < MROWS; row += NGW) {
        const int b = row >> 13; const float* mb = MOD + (size_t)b * 3072;
#pragma unroll
        for (int j = 0; j < 4; ++j) { const int col = 4 * lane + 256 * j;
            const f32x4 v = *(const f32x4*)(x + (size_t)row * DM + col), sh = *(const f32x4*)(mb + col), sc = *(const f32x4*)(mb + 1024 + col);
            const f32x4 u = v * sc + sh; u32x2 o; o.x = pk2(u[0], u[1]); o.y = pk2(u[2], u[3]);
            *(u32x2*)(U + (size_t)row * DM + col) = o; }
    }
}

DI void p_norm3(const Params& p) {
    const int tid = threadIdx.x, lane = tid & 63, wave = tid >> 6;
    const int gw = blockIdx.x * NWAVES + wave, NGW = gridDim.x * NWAVES;
    const bf16* Y1 = (const bf16*)(p.ws + WS_Y1); bf16* CQN = (bf16*)(p.ws + WS_CQN); bf16* CKVN = (bf16*)(p.ws + WS_CKVN); bf16* KR = (bf16*)(p.ws + WS_KROPE);
    const float* ROPE = (const float*)(p.ws + WS_ROPE);
    const f32x4 qg = *(const f32x4*)(p.in[8] + 4 * lane); const f32x2 kg = *(const f32x2*)(p.in[10] + 2 * lane);
    for (int row = gw; row < MROWS; row += NGW) {
        const bf16* yr = Y1 + (size_t)row * 2048;
        const u32x2 a = *(const u32x2*)(yr + 4 * lane); const unsigned kvv = *(const unsigned*)(yr + 256 + 2 * lane);
        float v0 = bflo(a.x), v1 = bfhi(a.x), v2 = bflo(a.y), v3 = bfhi(a.y);
        float ss = wave_sum(v0 * v0 + v1 * v1 + v2 * v2 + v3 * v3);
        float rs = 1.0f / sqrtf(ss * (1.f / 256.f) + 1e-6f);
        u32x2 o; o.x = pk2(v0 * rs * qg[0], v1 * rs * qg[1]); o.y = pk2(v2 * rs * qg[2], v3 * rs * qg[3]);
        *(u32x2*)(CQN + (size_t)row * 256 + 4 * lane) = o;
        float w0 = bflo(kvv), w1 = bfhi(kvv);
        ss = wave_sum(w0 * w0 + w1 * w1); rs = 1.0f / sqrtf(ss * (1.f / 128.f) + 1e-6f);
        *(unsigned*)(CKVN + (size_t)row * 128 + 2 * lane) = pk2(w0 * rs * kg[0], w1 * rs * kg[1]);
        if (lane < 16) { const int pos = row & (SEQ - 1);
            const float x1 = bflo((unsigned)yr[384 + lane]), x2 = bflo((unsigned)yr[400 + lane]);
            const float cs = ROPE[pos * 16 + lane], sn = ROPE[SEQ * 16 + pos * 16 + lane];
            KR[(size_t)row * 32 + lane] = (bf16)(pk2(x1 * cs - x2 * sn, 0.f) & 0xffffu);
            KR[(size_t)row * 32 + 16 + lane] = (bf16)(pk2(x1 * sn + x2 * cs, 0.f) & 0xffffu); }
    }
}

DI void p_ln(const Params& p, int lnidx, int next_sub, bool do_fl) {
    const int tid = threadIdx.x, lane = tid & 63, wave = tid >> 6;
    const int gw = blockIdx.x * NWAVES + wave, NGW = gridDim.x * NWAVES;
    float* X = p.out; const float* g = p.in[4] + lnidx * 1024; const float* bt = p.in[5] + lnidx * 1024;
    const float* MOD = (const float*)(p.ws + WS_MOD); bf16* U = (bf16*)(p.ws + WS_U);
    const float* wf = p.in[18] + 1536; const float* bfv = p.in[19]; float* LF = (float*)(p.ws + WS_LF);
    for (int row = gw; row < MROWS; row += NGW) {
        const int b = row >> 13;
        f32x4 v[4]; float s = 0.f;
#pragma unroll
        for (int j = 0; j < 4; ++j) { v[j] = *(const f32x4*)(X + (size_t)row * DM + 4 * lane + 256 * j); s += (v[j][0] + v[j][1]) + (v[j][2] + v[j][3]); }
        const float mean = wave_sum(s) * (1.f / 1024.f); float s2 = 0.f;
#pragma unroll
        for (int j = 0; j < 4; ++j) { v[j] = v[j] - mean; s2 += (v[j][0] * v[j][0] + v[j][1] * v[j][1]) + (v[j][2] * v[j][2] + v[j][3] * v[j][3]); }
        const float rstd = 1.0f / sqrtf(wave_sum(s2) * (1.f / 1024.f) + 1e-5f);
        float fa[8] = {0.f, 0.f, 0.f, 0.f, 0.f, 0.f, 0.f, 0.f};
#pragma unroll
        for (int j = 0; j < 4; ++j) { const int col = 4 * lane + 256 * j;
            const f32x4 xn = v[j] * rstd * *(const f32x4*)(g + col) + *(const f32x4*)(bt + col);
            *(f32x4*)(X + (size_t)row * DM + col) = xn;
            if (next_sub >= 0) { const float* mb = MOD + (size_t)(next_sub * 4 + b) * 3072;
                const f32x4 u = xn * *(const f32x4*)(mb + 1024 + col) + *(const f32x4*)(mb + col);
                u32x2 o; o.x = pk2(u[0], u[1]); o.y = pk2(u[2], u[3]); *(u32x2*)(U + (size_t)row * DM + col) = o;
                if (do_fl) {
#pragma unroll
                    for (int e = 0; e < 4; ++e) { const f32x4 w0 = *(const f32x4*)(wf + (size_t)(col + e) * 3080), w1 = *(const f32x4*)(wf + (size_t)(col + e) * 3080 + 4);
                        fa[0] += u[e] * w0[0]; fa[1] += u[e] * w0[1]; fa[2] += u[e] * w0[2]; fa[3] += u[e] * w0[3];
                        fa[4] += u[e] * w1[0]; fa[5] += u[e] * w1[1]; fa[6] += u[e] * w1[2]; fa[7] += u[e] * w1[3]; } } }
        }
        if (do_fl) {
#pragma unroll
            for (int h = 0; h < 8; ++h) fa[h] = wave_sum(fa[h]);
            if (lane < 8) {
                float xv = fa[0];
#pragma unroll
                for (int h = 1; h < 8; ++h) xv = (lane == h) ? fa[h] : xv;
                xv += bfv[lane];
                const float lf = fminf(xv, 0.f) - log1pf(expf(-fabsf(xv)));
                LF[(size_t)(b * 8 + lane) * SEQ + (row & (SEQ - 1))] = lf; }
        }
    }
}

DI void p_conv(const Params& p, int layer) {
    const bf16* Gb = (const bf16*)(p.ws + WS_G); bf16* Hb = (bf16*)(p.ws + WS_H);
    const float* cw = p.in[24] + (size_t)layer * 3 * DFF; const float* cbv = p.in[25] + (size_t)layer * DFF;
    const int total = (MROWS / 32) * (DFF / 8);
    for (int it = blockIdx.x * NTHR + threadIdx.x; it < total; it += gridDim.x * NTHR) {
        const int rb = it / (DFF / 8), ch = it % (DFF / 8), row0 = rb * 32, c0 = ch * 8;
        float w0[8], w1[8], w2[8], cb[8], gm2[8], gm1[8];
#pragma unroll
        for (int h = 0; h < 2; ++h) { const f32x4 a = *(const f32x4*)(cw + c0 + 4 * h), b = *(const f32x4*)(cw + DFF + c0 + 4 * h), c = *(const f32x4*)(cw + 2 * DFF + c0 + 4 * h), d = *(const f32x4*)(cbv + c0 + 4 * h);
#pragma unroll
            for (int e = 0; e < 4; ++e) { w0[4 * h + e] = a[e]; w1[4 * h + e] = b[e]; w2[4 * h + e] = c[e]; cb[4 * h + e] = d[e]; } }
        if ((row0 & (SEQ - 1)) == 0) {
#pragma unroll
            for (int e = 0; e < 8; ++e) { gm2[e] = 0.f; gm1[e] = 0.f; }
        } else {
            const u32x4 a = *(const u32x4*)(Gb + (size_t)(row0 - 2) * DFF + c0), b = *(const u32x4*)(Gb + (size_t)(row0 - 1) * DFF + c0);
#pragma unroll
            for (int e = 0; e < 4; ++e) { gm2[2 * e] = bflo(a[e]); gm2[2 * e + 1] = bfhi(a[e]); gm1[2 * e] = bflo(b[e]); gm1[2 * e + 1] = bfhi(b[e]); }
        }
#pragma unroll 4
        for (int r = 0; r < 32; ++r) {
            const size_t off = (size_t)(row0 + r) * DFF + c0;
            const u32x4 gv = *(const u32x4*)(Gb + off), vv = *(const u32x4*)(Hb + off);
            float g0[8], hv[8];
#pragma unroll
            for (int e = 0; e < 4; ++e) { g0[2 * e] = bflo(gv[e]); g0[2 * e + 1] = bfhi(gv[e]); }
#pragma unroll
            for (int e = 0; e < 8; ++e) { const float pre = w0[e] * gm2[e] + w1[e] * gm1[e] + w2[e] * g0[e] + cb[e];
                const float sl = pre * __builtin_amdgcn_rcpf(1.f + __expf(-pre)); const float vval = (e & 1) ? bfhi(vv[e >> 1]) : bflo(vv[e >> 1]);
                hv[e] = sl * vval; gm2[e] = gm1[e]; gm1[e] = g0[e]; }
            u32x4 o; o.x = pk2(hv[0], hv[1]); o.y = pk2(hv[2], hv[3]); o.z = pk2(hv[4], hv[5]); o.w = pk2(hv[6], hv[7]);
            *(u32x4*)(Hb + off) = o;
        }
    }
}

DI void p_scan(const Params& p, LAS unsigned char* lds) {
    if (blockIdx.x >= 32) return;
    const int tid = threadIdx.x, lane = tid & 63, wave = tid >> 6;
    const float* LF = (const float*)(p.ws + WS_LF) + (size_t)blockIdx.x * SEQ; float* F = (float*)(p.ws + WS_F) + (size_t)blockIdx.x * SEQ;
    LAS float* wsum = (LAS float*)lds;
    f32x4 v[4]; float s = 0.f;
#pragma unroll
    for (int j = 0; j < 4; ++j) { v[j] = *(const f32x4*)(LF + tid * 16 + 4 * j);
#pragma unroll
        for (int e = 0; e < 4; ++e) { s += v[j][e]; v[j][e] = s; } }
    float inc = s;
#pragma unroll
    for (int o = 1; o < 64; o <<= 1) { const float t = __shfl_up(inc, o); if (lane >= o) inc += t; }
    if (lane == 63) wsum[wave] = inc;
    __syncthreads();
    float off = inc - s;
#pragma unroll
    for (int w = 0; w < 8; ++w) off += (w < wave) ? wsum[w] : 0.f;
#pragma unroll
    for (int j = 0; j < 4; ++j) *(f32x4*)(F + tid * 16 + 4 * j) = v[j] + off;
    __syncthreads();
}

struct EpiResid {
    static constexpr bool PERM = true, AFTER_DRAIN = false;
    const float* xin; float* xout; const float* gate;
    __device__ __forceinline__ void operator()(const pg8::f32x4 (&acc)[2][2][4][2], const pg8::Unit& u, int wr, int wc, int fr, int fq) const {
        const int row0 = u.pm * 256 + wr * 64 + fr, col0 = u.pn * 256 + wc * 32 + 8 * fq, b = (u.pm * 256) >> 13;
        f32x4 gv[2][2];
#pragma unroll
        for (int bj = 0; bj < 2; ++bj)
#pragma unroll
            for (int n = 0; n < 2; ++n) gv[bj][n] = *(const f32x4*)(gate + (size_t)b * 3072 + col0 + bj * 128 + 4 * n);
#pragma unroll
        for (int ai = 0; ai < 2; ++ai)
#pragma unroll
            for (int m = 0; m < 4; ++m) { const size_t off = (size_t)(row0 + ai * 128 + m * 16) * DM + col0;
#pragma unroll
                for (int bj = 0; bj < 2; ++bj)
#pragma unroll
                    for (int n = 0; n < 2; ++n) { const f32x4 xi = *(const f32x4*)(xin + off + bj * 128 + 4 * n);
                        const f32x4 o = xi * ALPHA + gv[bj][n] * acc[ai][bj][m][n]; *(f32x4*)(xout + off + bj * 128 + 4 * n) = o; } }
    }
};

namespace att {
constexpr int KBUF = 64 * 208, VBUF = 64 * 288;
constexpr int OFF_K = 0, OFF_V = 2 * KBUF, OFF_KB = 2 * KBUF + 2 * VBUF, OFF_TAB = OFF_KB + 512, LDS_END = OFF_TAB + 1024;
constexpr float NEG = -1e30f;
struct Src { const float* rope; const bf16* q; const bf16* q2; int qpitch; const bf16* k; const bf16* k2; int kpitch; const bf16* v; int vpitch; const float* f; float fref; };
#define MFMA32(a, b, c) __builtin_amdgcn_mfma_f32_32x32x16_bf16((a), (b), (c), 0, 0, 0)
typedef short v4i16_t __attribute__((ext_vector_type(4)));
DI s16x4 vtr(LAS unsigned char* ptr) { return __builtin_bit_cast(s16x4, __builtin_amdgcn_ds_read_tr16_b64_v4i16((LAS v4i16_t*)ptr)); }

template <int DQK, int DV, int MODE>
DI void core(LAS unsigned char* lds, const Src& s, int q0, int TLO, int THI, int tlo_w, int thi_w, int near_lo, float farc, f32x16 (&o)[DV / 32], float& l_out) {
    constexpr int KROW = DQK * 2 + 16, VROW = (DV == 128) ? 288 : 144, ND = DQK / 16, NC = DV / 32;
    const int tid = threadIdx.x, lane = tid & 63, r = lane & 31, h = lane >> 5;
    const int wid = __builtin_amdgcn_readfirstlane(tid >> 6);
    bf16x8 qf[ND];
    { const bf16* qp = s.q + (size_t)(q0 + 32 * wid + r) * s.qpitch + 8 * h;
#pragma unroll
      for (int d0 = 0; d0 < 4; ++d0) qf[d0] = *(const bf16x8*)(qp + 16 * d0);
      if constexpr (DQK == 96) { const bf16* q2p = s.q2 + (size_t)(q0 + 32 * wid + r) * s.qpitch + 8 * h;
          const u32x4 x1 = *(const u32x4*)(q2p), x2 = *(const u32x4*)(q2p + 16);
          const float* rp = s.rope + (size_t)(q0 + 32 * wid + r) * 16 + 8 * h;
          const f32x4 c0 = *(const f32x4*)(rp), c1 = *(const f32x4*)(rp + 4), s0 = *(const f32x4*)(rp + SEQ * 16), s1 = *(const f32x4*)(rp + SEQ * 16 + 4);
          u32x4 y1, y2;
#pragma unroll
          for (int e = 0; e < 4; ++e) { const float a0 = bflo(x1[e]), a1 = bfhi(x1[e]), b0 = bflo(x2[e]), b1 = bfhi(x2[e]);
              const float cl = e < 2 ? c0[2 * e] : c1[2 * e - 4], ch = e < 2 ? c0[2 * e + 1] : c1[2 * e - 3], sl = e < 2 ? s0[2 * e] : s1[2 * e - 4], sh = e < 2 ? s0[2 * e + 1] : s1[2 * e - 3];
              y1[e] = pk2(a0 * cl - b0 * sl, a1 * ch - b1 * sh); y2[e] = pk2(a0 * sl + b0 * cl, a1 * sh + b1 * ch); }
          qf[4] = __builtin_bit_cast(bf16x8, y1); qf[5] = __builtin_bit_cast(bf16x8, y2); } }
#pragma unroll
    for (int c = 0; c < NC; ++c)
#pragma unroll
        for (int i = 0; i < 16; ++i) o[c][i] = 0.f;
    float m_run = 0.f, l_run = 0.f;
    u32x4 kr, k2r, vr0, vr1; float fr_ = 0.f;
    kr = (u32x4){0u, 0u, 0u, 0u}; k2r = kr; vr0 = kr; vr1 = kr;
#define ATT_ISSUE(t) do { const size_t key0 = (size_t)(t) * 64; \
        kr = *(const u32x4*)(s.k + (key0 + (tid >> 3)) * s.kpitch + (tid & 7) * 8); \
        if constexpr (DQK == 96) { if (tid < 256) k2r = *(const u32x4*)(s.k2 + (key0 + (tid >> 2)) * 32 + (tid & 3) * 8); } \
        if constexpr (DV == 64) { vr0 = *(const u32x4*)(s.v + (key0 + (tid >> 3)) * s.vpitch + (tid & 7) * 8); } \
        else { vr0 = *(const u32x4*)(s.v + (key0 + (tid >> 4)) * s.vpitch + (tid & 15) * 8); vr1 = *(const u32x4*)(s.v + (key0 + 32 + (tid >> 4)) * s.vpitch + (tid & 15) * 8); } \
        if constexpr (MODE == 2) { if (tid < 64) fr_ = s.f[key0 + tid]; } } while (0)
#define ATT_COMMIT(buf) do { LAS unsigned char* kb_ = lds + OFF_K + (buf) * KBUF; LAS unsigned char* vb_ = lds + OFF_V + (buf) * VBUF; \
        *(LAS u32x4*)(kb_ + (tid >> 3) * KROW + (tid & 7) * 16) = kr; \
        if constexpr (DQK == 96) { if (tid < 256) *(LAS u32x4*)(kb_ + (tid >> 2) * KROW + 128 + (tid & 3) * 16) = k2r; } \
        if constexpr (DV == 64) { *(LAS u32x4*)(vb_ + (tid >> 3) * VROW + (tid & 7) * 16) = vr0; } \
        else { *(LAS u32x4*)(vb_ + (tid >> 4) * VROW + (tid & 15) * 16) = vr0; *(LAS u32x4*)(vb_ + (32 + (tid >> 4)) * VROW + (tid & 15) * 16) = vr1; } \
        if constexpr (MODE == 2) { if (tid < 64) ((LAS float*)(lds + OFF_KB))[(buf) * 64 + tid] = (s.fref - fr_) * LOG2E; } } while (0)
#define ATT_BAR() asm volatile("s_waitcnt lgkmcnt(0)\n\ts_barrier" ::: "memory")
    const int i16 = lane & 15, q4 = i16 >> 2, pp = i16 & 3, blk = (lane >> 4) & 1;
    const int voff = (4 * h + q4) * VROW + blk * 32 + pp * 8;
    bf16x8 pa[4];
    constexpr float THR = 8.f;
#define ATT_S1(t, buf) do { \
        LAS unsigned char* kb = lds + OFF_K + (buf) * KBUF; \
        f32x16 p0, p1; \
        if constexpr (MODE == 0) { _Pragma("unroll") for (int i = 0; i < 16; ++i) { p0[i] = -m_run; p1[i] = -m_run; } } \
        if constexpr (MODE == 1) { \
            if ((t) >= near_lo) { const LAS float* tab = (const LAS float*)(lds + OFF_TAB); const int base = (q0 + 32 * wid + r) - 64 * (t) + 63 - 4 * h; \
                _Pragma("unroll") for (int i = 0; i < 16; ++i) { const int kk = (i & 3) + 8 * (i >> 2); p0[i] = tab[base - kk] - m_run; p1[i] = tab[base - 32 - kk] - m_run; } } \
            else { const float c_ = farc - m_run; _Pragma("unroll") for (int i = 0; i < 16; ++i) { p0[i] = c_; p1[i] = c_; } } } \
        if constexpr (MODE == 2) { const LAS float* kbp = (const LAS float*)(lds + OFF_KB) + (buf) * 64; \
            _Pragma("unroll") for (int g = 0; g < 4; ++g) { const f32x4 b0 = *(const LAS f32x4*)(kbp + 8 * g + 4 * h), b1 = *(const LAS f32x4*)(kbp + 32 + 8 * g + 4 * h); \
                _Pragma("unroll") for (int e = 0; e < 4; ++e) { p0[4 * g + e] = b0[e] - m_run; p1[4 * g + e] = b1[e] - m_run; } } } \
        _Pragma("unroll") for (int d0 = 0; d0 < ND; ++d0) { \
            const bf16x8 k0 = *(const LAS bf16x8*)(kb + r * KROW + d0 * 32 + h * 16); \
            const bf16x8 k1 = *(const LAS bf16x8*)(kb + (32 + r) * KROW + d0 * 32 + h * 16); \
            p0 = MFMA32(k0, qf[d0], p0); p1 = MFMA32(k1, qf[d0], p1); } \
        if constexpr (MODE == 2) { if ((t) == thi_w) { const int qq = 32 * (wid & 1) + r; \
            _Pragma("unroll") for (int i = 0; i < 16; ++i) { const int kk = (i & 3) + 8 * (i >> 2) + 4 * h; if (kk > qq) p0[i] = NEG; if (kk + 32 > qq) p1[i] = NEG; } } } \
        float rm = fmaxf(fmaxf(p0[0], p0[1]), p1[0]); \
        _Pragma("unroll") for (int i = 2; i < 16; i += 2) rm = fmaxf(fmaxf(rm, p0[i]), p0[i + 1]); \
        _Pragma("unroll") for (int i = 1; i < 15; i += 2) rm = fmaxf(fmaxf(rm, p1[i]), p1[i + 1]); \
        rm = fmaxf(rm, p1[15]); \
        rm = fmaxf(rm, __shfl_xor(rm, 32)); \
        const bool first_ = ((t) == tlo_w); \
        if (first_ || __any(rm > THR)) { \
            const float dl = first_ ? rm : fmaxf(rm, 0.f); m_run += dl; \
            _Pragma("unroll") for (int i = 0; i < 16; ++i) { p0[i] -= dl; p1[i] -= dl; } \
            const float alpha = first_ ? 1.f : __builtin_amdgcn_exp2f(-dl); l_run *= alpha; \
            _Pragma("unroll") for (int c = 0; c < NC; ++c) _Pragma("unroll") for (int i = 0; i < 16; ++i) o[c][i] *= alpha; } \
        float rs0 = 0.f, rs1 = 0.f; \
        _Pragma("unroll") for (int i = 0; i < 16; ++i) { p0[i] = __builtin_amdgcn_exp2f(p0[i]); p1[i] = __builtin_amdgcn_exp2f(p1[i]); rs0 += p0[i]; rs1 += p1[i]; } \
        l_run += rs0 + rs1; \
        { u32x4 w; \
          w.x = pk2(p0[0], p0[1]); w.y = pk2(p0[2], p0[3]); w.z = pk2(p0[4], p0[5]); w.w = pk2(p0[6], p0[7]); pa[0] = __builtin_bit_cast(bf16x8, w); \
          w.x = pk2(p0[8], p0[9]); w.y = pk2(p0[10], p0[11]); w.z = pk2(p0[12], p0[13]); w.w = pk2(p0[14], p0[15]); pa[1] = __builtin_bit_cast(bf16x8, w); \
          w.x = pk2(p1[0], p1[1]); w.y = pk2(p1[2], p1[3]); w.z = pk2(p1[4], p1[5]); w.w = pk2(p1[6], p1[7]); pa[2] = __builtin_bit_cast(bf16x8, w); \
          w.x = pk2(p1[8], p1[9]); w.y = pk2(p1[10], p1[11]); w.z = pk2(p1[12], p1[13]); w.w = pk2(p1[14], p1[15]); pa[3] = __builtin_bit_cast(bf16x8, w); } \
    } while (0)
#define ATT_PV(buf) do { LAS unsigned char* vb = lds + OFF_V + (buf) * VBUF; \
        _Pragma("unroll") for (int c = 0; c < NC; ++c) _Pragma("unroll") for (int ks = 0; ks < 4; ++ks) { \
            const s16x4 lo = vtr(vb + voff + ks * 16 * VROW + c * 64), hi = vtr(vb + voff + ks * 16 * VROW + 8 * VROW + c * 64); \
            const bf16x8 vf = __builtin_shufflevector(lo, hi, 0, 1, 2, 3, 4, 5, 6, 7); \
            o[c] = MFMA32(vf, pa[ks], o[c]); if (NC == 4 && ks == 3) __builtin_amdgcn_sched_barrier(0); } } while (0)
    ATT_ISSUE(TLO); ATT_COMMIT(0);
    ATT_BAR();
    for (int t = TLO; t <= THI; ++t) {
        const int buf = (t - TLO) & 1;
        if (t < THI) ATT_ISSUE(t + 1);
        if (t >= tlo_w && t <= thi_w) { ATT_S1(t, buf); ATT_PV(buf); }
        if (t < THI) ATT_COMMIT(buf ^ 1);
        ATT_BAR();
    }
#undef ATT_ISSUE
#undef ATT_COMMIT
#undef ATT_S1
#undef ATT_PV
#undef ATT_BAR
    l_out = l_run + __shfl_xor(l_run, 32);
}

DI int t5_bucket(int rel) {
    const int n = rel < 0 ? -rel : rel; int b;
    if (n < 8) b = n; else if (n < 12) b = 8; else if (n < 16) b = 9; else if (n < 23) b = 10; else if (n < 32) b = 11; else if (n < 46) b = 12; else if (n < 64) b = 13; else if (n < 91) b = 14; else b = 15;
    return (rel > 0 ? 16 : 0) + b;
}
template <int NC> DI void store_o(const f32x16 (&o)[NC], float inv, bf16* O, int h) {
#pragma unroll
    for (int c = 0; c < NC; ++c)
#pragma unroll
        for (int g = 0; g < 4; ++g) { u32x2 w; w.x = pk2(o[c][4 * g] * inv, o[c][4 * g + 1] * inv); w.y = pk2(o[c][4 * g + 2] * inv, o[c][4 * g + 3] * inv);
            *(u32x2*)(O + 32 * c + 8 * g + 4 * h) = w; }
}

DI void phase_ab(const Params& p, LAS unsigned char* lds, int vcu, int G) {
    const int tid = threadIdx.x, lane = tid & 63, r = lane & 31, h = lane >> 5, wid = __builtin_amdgcn_readfirstlane(tid >> 6);
    const bf16* QA = (const bf16*)(p.ws + WS_QA); const bf16* KV = (const bf16*)(p.ws + WS_KV); const bf16* KR = (const bf16*)(p.ws + WS_KROPE);
    const bf16* Y1 = (const bf16*)(p.ws + WS_Y1); bf16* MRG = (bf16*)(p.ws + WS_U);
    for (int i = 0;; ++i) {
        const int idx = i * G + vcu; if (idx >= 1024) break;
        const int slot = idx >> 8, v = idx & 255, bh = v >> 3, sx = v & 7, b = bh >> 3, hd = bh & 7;
        const int qb = slot == 0 ? sx : slot == 1 ? 15 - sx : slot == 2 ? 16 + sx : 31 - sx;
        Src s; s.rope = (const float*)(p.ws + WS_ROPE); s.q = QA + (size_t)b * SEQ * 768 + hd * 64; s.q2 = QA + (size_t)b * SEQ * 768 + 512 + hd * 32; s.qpitch = 768;
        s.k = KV + (size_t)b * SEQ * 1024 + hd * 64; s.k2 = KR + (size_t)b * SEQ * 32; s.kpitch = 1024; s.v = KV + (size_t)b * SEQ * 1024 + 512 + hd * 64; s.vpitch = 1024; s.f = nullptr; s.fref = 0.f;
        f32x16 o[2]; float l;
        core<96, 64, 0>(lds, s, qb * 256, 0, 4 * qb + 3, 0, 4 * qb + (wid >> 1), 0, 0.f, o, l);
        store_o<2>(o, 1.0f / l, MRG + (size_t)(b * SEQ + qb * 256 + 32 * wid + r) * DM + hd * 64, h);
    }
    const float lam = ((const float*)(p.ws + WS_MISC))[0];
    for (int i = 0;; ++i) {
        const int idx = i * G + vcu; if (idx >= 512) break;
        const int slot = idx >> 8, v = idx & 255, bh = v >> 4, sx = v & 15, b = bh >> 2, hb = bh & 3;
        const int qb = slot == 0 ? sx : 31 - sx;
        if (tid < 255) ((LAS float*)(lds + OFF_TAB))[tid] = p.in[6][hb * 32 + t5_bucket(63 - tid)] * LOG2E;
        const float farc = p.in[6][hb * 32 + 15] * LOG2E;
        bf16* O = MRG + (size_t)(b * SEQ + qb * 256 + 32 * wid + r) * DM + 512 + hb * 128;
#pragma unroll
        for (int comp = 0; comp < 2; ++comp) {
            Src s; s.rope = nullptr; const bf16* yb = Y1 + (size_t)b * SEQ * 2048;
            s.q = yb + 416 + hb * 128 + comp * 64; s.q2 = nullptr; s.qpitch = 2048; s.k = yb + 928 + hb * 128 + comp * 64; s.k2 = nullptr; s.kpitch = 2048;
            s.v = yb + 1440 + hb * 128; s.vpitch = 2048; s.f = nullptr; s.fref = 0.f;
            f32x16 o[4]; float l; const int cw = 4 * qb + (wid >> 1);
            core<64, 128, 1>(lds, s, qb * 256, 0, 4 * qb + 3, 0, cw, cw - 2, farc, o, l);
            const float inv = 1.0f / l;
            if (comp == 0) {
                store_o<4>(o, inv, O, h);
            } else {
                const float li = lam * inv; float ss = 0.f;
#pragma unroll
                for (int c = 0; c < 4; ++c)
#pragma unroll
                    for (int g = 0; g < 4; ++g) { const u32x2 w0 = *(const u32x2*)(O + 32 * c + 8 * g + 4 * h);
                        o[c][4 * g] = bflo(w0.x) - li * o[c][4 * g]; o[c][4 * g + 1] = bfhi(w0.x) - li * o[c][4 * g + 1];
                        o[c][4 * g + 2] = bflo(w0.y) - li * o[c][4 * g + 2]; o[c][4 * g + 3] = bfhi(w0.y) - li * o[c][4 * g + 3];
                        ss += (o[c][4 * g] * o[c][4 * g] + o[c][4 * g + 1] * o[c][4 * g + 1]) + (o[c][4 * g + 2] * o[c][4 * g + 2] + o[c][4 * g + 3] * o[c][4 * g + 3]); }
                ss += __shfl_xor(ss, 32);
                const float rstd = 0.8f / sqrtf(ss * (1.f / 128.f) + 1e-6f);
#pragma unroll
                for (int c = 0; c < 4; ++c)
#pragma unroll
                    for (int g = 0; g < 4; ++g) { const f32x4 sg = *(const f32x4*)(p.in[16] + 32 * c + 8 * g + 4 * h);
                        u32x2 w; w.x = pk2(o[c][4 * g] * rstd * sg[0], o[c][4 * g + 1] * rstd * sg[1]); w.y = pk2(o[c][4 * g + 2] * rstd * sg[2], o[c][4 * g + 3] * rstd * sg[3]);
                        *(u32x2*)(O + 32 * c + 8 * g + 4 * h) = w; }
            }
        }
    }
}

DI void phase_cd(const Params& p, LAS unsigned char* lds, int vcu, int G) {
    const int tid = threadIdx.x, lane = tid & 63, r = lane & 31, h = lane >> 5, wid = __builtin_amdgcn_readfirstlane(tid >> 6);
    const bf16* QKV = (const bf16*)(p.ws + WS_QKV1); bf16* MRG = (bf16*)(p.ws + WS_MRG1); const float* F = (const float*)(p.ws + WS_F);
    for (int i = 0;; ++i) {
        const int idx = i * G + vcu; if (idx >= 1024) break;
        const int slot = idx >> 8, v = idx & 255, bh = v >> 3, sx = v & 7, b = bh >> 3, hd = bh & 7;
        const int qb = slot == 0 ? sx : slot == 1 ? 15 - sx : slot == 2 ? 16 + sx : 31 - sx;
        const bf16* yb = QKV + (size_t)b * SEQ * 3072;
        Src s; s.rope = nullptr; s.q = yb + hd * 64; s.q2 = nullptr; s.qpitch = 3072; s.k = yb + 512 + hd * 64; s.k2 = nullptr; s.kpitch = 3072; s.v = yb + 1024 + hd * 64; s.vpitch = 3072;
        s.f = F + (size_t)bh * SEQ; s.fref = s.f[qb * 256];
        f32x16 o[2]; float l;
        core<64, 64, 2>(lds, s, qb * 256, 0, 4 * qb + 3, 0, 4 * qb + (wid >> 1), 0, 0.f, o, l);
        store_o<2>(o, 1.0f / l, MRG + (size_t)(b * SEQ + qb * 256 + 32 * wid + r) * DM + hd * 64, h);
    }
    for (int i = 0;; ++i) {
        const int idx = i * G + vcu; if (idx >= 1024) break;
        const int slot = idx >> 8, v = idx & 255, bh = v >> 3, sx = v & 7, b = bh >> 3, hd = bh & 7;
        const int qb = 4 * sx + slot;
        const float* rt = p.in[20] + hd * 257;
        if (tid < 255) { int d = tid - 63; d = d < -128 ? -128 : (d > 128 ? 128 : d); ((LAS float*)(lds + OFF_TAB))[tid] = rt[d + 128] * LOG2E; }
        const float farc = rt[256] * LOG2E;
        const bf16* yb = QKV + (size_t)b * SEQ * 3072;
        Src s; s.rope = nullptr; s.q = yb + 1536 + hd * 64; s.q2 = nullptr; s.qpitch = 3072; s.k = yb + 2048 + hd * 64; s.k2 = nullptr; s.kpitch = 3072; s.v = yb + 2560 + hd * 64; s.vpitch = 3072; s.f = nullptr; s.fref = 0.f;
        f32x16 o[2]; float l; const int cw = 4 * qb + (wid >> 1);
        const int TLO = (4 * qb - 8) > 0 ? (4 * qb - 8) : 0, tlo_w = (cw - 8) > 0 ? (cw - 8) : 0;
        core<64, 64, 1>(lds, s, qb * 256, TLO, 4 * qb + 3, tlo_w, cw, cw - 2, farc, o, l);
        store_o<2>(o, 1.0f / l, MRG + (size_t)(b * SEQ + qb * 256 + 32 * wid + r) * DM + 512 + hd * 64, h);
    }
}
}

#define XB_TMO      128
#define XB_XCNT(j)  (256  + 64 * (j))
#define XB_XSUB(j)  (1280 + 64 * (j))
#define XB_XGEN(j)  (2304 + 64 * (j))
#define XB_TOP      3328
#define XB_TOPGEN   3392
#define XCD_BAR_WORDS 3456
#define XB_SPIN_CAP (1u << 18)

__device__ __forceinline__ unsigned xb_ld(unsigned* p)              { return __hip_atomic_load(p, __ATOMIC_RELAXED, __HIP_MEMORY_SCOPE_AGENT); }
__device__ __forceinline__ unsigned xb_add(unsigned* p, unsigned v) { return __hip_atomic_fetch_add(p, v, __ATOMIC_RELAXED, __HIP_MEMORY_SCOPE_AGENT); }
__device__ __forceinline__ unsigned xb_xcc_id() { return (unsigned)__builtin_amdgcn_s_getreg((3 << 11) | 20) & 0xFu; }
#define XB_SPIN(cond, bar) do { unsigned _sp = 0; while (cond) { __builtin_amdgcn_s_sleep(1); \
    if ((++_sp & 255u) == 0u) { if (xb_ld(&(bar)[XB_TMO])) break; if (_sp > XB_SPIN_CAP) { atomicAdd(&(bar)[XB_TMO], 1u); break; } } } } while (0)

struct XcdBarrier {
    unsigned* bar; unsigned x;
    volatile LAS unsigned* st;
};

__device__ __forceinline__ XcdBarrier xcd_barrier_post(unsigned* bar, volatile LAS unsigned* st) {
    XcdBarrier b; b.bar = bar; b.x = xb_xcc_id(); b.st = st;
    if (threadIdx.x == 0) (void)xb_add(&bar[XB_XCNT(b.x)], 1u);
    return b;
}
__device__ __forceinline__ void xcd_barrier_complete(unsigned* bar, unsigned x, unsigned& nloc, unsigned& nx) {
    const unsigned G = gridDim.x * gridDim.y * gridDim.z;
    unsigned sum, cnt, mine, sp = 0u;
    for (;;) {
        sum = 0u; cnt = 0u; mine = 0u;
#pragma unroll
        for (unsigned j = 0; j < 16; ++j) { const unsigned c = xb_ld(&bar[XB_XCNT(j)]); sum += c; cnt += (c > 0u) ? 1u : 0u; mine = (j == x) ? c : mine; }
        if (sum == G) break;
        __builtin_amdgcn_s_sleep(1);
        if ((++sp & 255u) == 0u) { if (xb_ld(&bar[XB_TMO])) break; if (sp > XB_SPIN_CAP) { atomicAdd(&bar[XB_TMO], 1u); break; } }
    }
    nloc = mine > 0u ? mine : 1u; nx = cnt > 0u ? cnt : 1u;
}

__device__ __forceinline__ void xcd_barrier(const XcdBarrier& b) {
    asm volatile("s_waitcnt vmcnt(0)" ::: "memory");
    __syncthreads();
    if (threadIdx.x == 0) {
        unsigned* bar = b.bar;
        __builtin_amdgcn_s_waitcnt(0);
        unsigned nloc = b.st[0], nx = b.st[1];
        if (nloc == 0u) { xcd_barrier_complete(bar, b.x, nloc, nx); b.st[0] = nloc; b.st[1] = nx; }
        const unsigned old = xb_add(&bar[XB_XSUB(b.x)], 1u);
        const unsigned gen = old / nloc;
        if (old + 1u == (gen + 1u) * nloc) {
            __builtin_amdgcn_fence(__ATOMIC_RELEASE, "agent");
            asm volatile("s_waitcnt vmcnt(0)" ::: "memory");
            const unsigned og = xb_add(&bar[XB_TOP], 1u);
            const unsigned tg = og / nx;
            if (og + 1u == (tg + 1u) * nx) xb_add(&bar[XB_TOPGEN], 1u);
            else XB_SPIN(xb_ld(&bar[XB_TOPGEN]) == tg, bar);
            __builtin_amdgcn_fence(__ATOMIC_ACQUIRE, "agent");
            xb_add(&bar[XB_XGEN(b.x)], 1u);
            asm volatile("s_waitcnt vmcnt(0)" ::: "memory");
        } else {
            XB_SPIN(xb_ld(&bar[XB_XGEN(b.x)]) == gen, bar);
            __builtin_amdgcn_fence(__ATOMIC_ACQUIRE, "agent");
            asm volatile("s_waitcnt vmcnt(0)" ::: "memory");
        }
    }
    __syncthreads();
}

constexpr int NPHASE = 20;
__global__ void __launch_bounds__(NTHR, 2) mega_fwd(Params p) {
    extern __shared__ __attribute__((aligned(16))) unsigned char lds_raw[];
    LAS unsigned char* lds = (LAS unsigned char*)lds_raw;
    cg::grid_group grid = cg::this_grid();
    const int G = gridDim.x, bx = blockIdx.x;
    const int vcu = (G % 8 == 0) ? (bx % 8) * (G / 8) + bx / 8 : bx;
    unsigned char* ws = p.ws;
    const float* MOD = (const float*)(ws + WS_MOD);
    typedef pg8::EpiBf16<0> EpiSt;
    volatile LAS unsigned* MISC = (volatile LAS unsigned*)(lds + 131072 + 512);
    if (threadIdx.x < 2) MISC[threadIdx.x] = 0u;
    __syncthreads();
    const XcdBarrier bar = xcd_barrier_post((unsigned*)(ws + WS_BAR), MISC);
#define IN(k) (p.lo <= (k) && (k) < p.hi)
#define SEAM(k) do { if (IN(k) && IN((k) + 1)) { if ((k) == 0) grid.sync(); else xcd_barrier(bar); } } while (0)
#define STORE_GEMM(Aoff, Woff, N_, K_, Ooff, ldc_, splitc, splits) do { \
        pg8::Gemm g{(const pg8::bf16_t*)(ws + (Aoff)), (const pg8::bf16_t*)(ws + (Woff)), MROWS, (N_), (K_)}; \
        EpiSt E{(pg8::bf16_t*)(ws + (Ooff)), (ldc_), nullptr, (splitc), (splits), 1.f}; \
        pg8::StaticOrder S; S.init(MROWS, (N_), G, bx); \
        pg8::gemm_phase<EpiSt, pg8::StaticOrder, true, true>(lds, g, S, E); } while (0)
#define RESID_GEMM(Aoff, Woff, K_, xin_, sub) do { \
        pg8::Gemm g{(const pg8::bf16_t*)(ws + (Aoff)), (const pg8::bf16_t*)(ws + (Woff)), MROWS, 1024, (K_)}; \
        EpiResid E{(xin_), p.out, MOD + (sub) * 4 * 3072 + 2048}; \
        pg8::StaticOrder S; S.init(MROWS, 1024, G, bx); \
        pg8::gemm_phase<EpiResid, pg8::StaticOrder, true, true>(lds, g, S, E); } while (0)
    if (IN(0)) p_prologue(p, lds);
    SEAM(0);
    if (IN(1)) p_modulate(p);
    SEAM(1);
    if (IN(2)) STORE_GEMM(WS_U, W_ABIN, 2048, 1024, WS_Y1, 2048, 0, 0);
    SEAM(2);
    if (IN(3)) p_norm3(p);
    SEAM(3);
    if (IN(4)) {
        STORE_GEMM(WS_CQN, W_UQ, 768, 256, WS_QA, 768, 0, 0);
        STORE_GEMM(WS_CKVN, W_UKV, 1024, 128, WS_KV, 1024, 0, 0);
    }
    SEAM(4);
    if (IN(5)) att::phase_ab(p, lds, vcu, G);
    SEAM(5);
    if (IN(6)) RESID_GEMM(WS_U, W_ABOUT, 1024, p.in[0], 0);
    SEAM(6);
    if (IN(7)) p_ln(p, 0, 1, false);
    SEAM(7);
    if (IN(8)) STORE_GEMM(WS_U, W_UP0, 2 * DFF, 1024, WS_G, DFF, DFF, (size_t)(WS_H - WS_G) / 2);
    SEAM(8);
    if (IN(9)) p_conv(p, 0);
    SEAM(9);
    if (IN(10)) RESID_GEMM(WS_H, W_DN0, DFF, p.out, 1);
    SEAM(10);
    if (IN(11)) p_ln(p, 1, 2, true);
    SEAM(11);
    if (IN(12)) { p_scan(p, lds); STORE_GEMM(WS_U, W_CDIN, 3072, 1024, WS_QKV1, 3072, 0, 0); }
    SEAM(12);
    if (IN(13)) att::phase_cd(p, lds, vcu, G);
    SEAM(13);
    if (IN(14)) RESID_GEMM(WS_MRG1, W_CDOUT, 1024, p.out, 2);
    SEAM(14);
    if (IN(15)) p_ln(p, 2, 3, false);
    SEAM(15);
    if (IN(16)) STORE_GEMM(WS_U, W_UP1, 2 * DFF, 1024, WS_G, DFF, DFF, (size_t)(WS_H - WS_G) / 2);
    SEAM(16);
    if (IN(17)) p_conv(p, 1);
    SEAM(17);
    if (IN(18)) RESID_GEMM(WS_H, W_DN1, DFF, p.out, 3);
    SEAM(18);
    if (IN(19)) p_ln(p, 3, -1, false);
}

extern "C" void kernel_launch(void* const* d_in, const int* in_sizes, int n_in, void* d_out, int out_size, void* d_ws, size_t ws_size, hipStream_t stream) {
    static int grid = 0;
    if (grid == 0) {
        if (n_in != 27 || out_size != MROWS * DM || ws_size < WS_END) { fprintf(stderr, "kernel_launch: unexpected shapes (n_in %d out %d ws %zu)\n", n_in, out_size, ws_size); grid = -1; return; }
        int dev = 0, cus = 0, per_cu = 0;
        (void)hipGetDevice(&dev); (void)hipDeviceGetAttribute(&cus, hipDeviceAttributeMultiprocessorCount, dev);
        if (hipFuncSetAttribute((const void*)mega_fwd, hipFuncAttributeMaxDynamicSharedMemorySize, LDS_BYTES) != hipSuccess) { fprintf(stderr, "kernel_launch: hipFuncSetAttribute failed\n"); grid = -1; return; }
        if (hipOccupancyMaxActiveBlocksPerMultiprocessor(&per_cu, (const void*)mega_fwd, NTHR, LDS_BYTES) != hipSuccess || per_cu < 1) { fprintf(stderr, "kernel_launch: occupancy query says %d\n", per_cu); per_cu = 1; }
        (void)hipGetLastError();
        grid = cus;
    }
    if (grid < 0) return;
    Params a{};
    for (int i = 0; i < 27; ++i) a.in[i] = (const float*)d_in[i];
    a.out = (float*)d_out; a.ws = (unsigned char*)d_ws; a.lo = 0; a.hi = NPHASE;
    if (hipMemsetAsync((char*)d_ws + WS_BAR, 0, 16384, stream) != hipSuccess) { fprintf(stderr, "kernel_launch: memset failed\n"); return; }
    void* args[] = {&a};
    hipError_t e = hipLaunchCooperativeKernel((const void*)mega_fwd, dim3(grid), dim3(NTHR), args, LDS_BYTES, stream);
    if (e != hipSuccess) fprintf(stderr, "cooperative launch failed: %s (grid %d)\n", hipGetErrorString(e), grid);
}
```

```cpp
#include <hip/hip_runtime.h>
#include <hip/hip_cooperative_groups.h>
#include <cstdio>
#include <cstdint>
namespace cg = cooperative_groups;
namespace pg8 {
#define PG8_LAS __attribute__((address_space(3)))
typedef unsigned short bf16_t;
typedef short bf16x8 __attribute__((ext_vector_type(8)));
typedef float f32x4 __attribute__((ext_vector_type(4)));
typedef unsigned u32x4 __attribute__((ext_vector_type(4)));
constexpr int BM = 256, BK = 64, HALF = 128, HTB = HALF * BK * 2  , STAGE_BYTES = 8 * HTB, NXCD = 8, WGM = 8;

__host__ __device__ __forceinline__ int lds_byte(int r, int c) { const int st = (r >> 4) * 2 + (c >> 5), rr = r & 15, cc = c & 31, ob = rr * 64 + cc * 2; return st * 1024 + (ob ^ (((ob >> 9) & 1) << 5)); }
__host__ __device__ __forceinline__ void stage_rc(int b, int& R, int& C) { const int st = b / 1024, sb = b % 1024, swz = sb ^ (((sb >> 9) & 1) << 5); R = (st >> 1) * 16 + swz / 64; C = (st & 1) * 32 + (swz % 64) / 2; }
__host__ __device__ __forceinline__ int perm32(int rho) { const int n = rho >> 4, i = rho & 15; return 8 * (i >> 2) + 4 * n + (i & 3); }

struct Unit { int pm, pn; };
struct Gemm { const bf16_t* A; const bf16_t* Bt; int M, N, K; };

struct StaticOrder {
    int nM, nN, nwg, G, c;
    __host__ __device__ void init(int M, int N, int G_, int c_) { nM = M / BM; nN = N / BM; nwg = nM * nN; G = G_; c = c_; }
    __host__ __device__ bool next(int i, Unit& u) const {
        const long L = (long)i * G + c; if (L >= nwg) return false;
        int wgid = (int)L; { const int q = nwg / NXCD, r = nwg % NXCD, xcd = wgid % NXCD, off = wgid / NXCD; wgid = (xcd < r ? xcd * (q + 1) : r * (q + 1) + (xcd - r) * q) + off; }
        const int nig = WGM * nN, gid = wgid / nig, fm = gid * WGM, gsz = (nM - fm) < WGM ? (nM - fm) : WGM;
        u.pm = fm + ((wgid % nig) % gsz); u.pn = (wgid % nig) / gsz; return true;
    }
    __device__ __forceinline__ long a_off(const Unit& u, size_t tstep) const { return (long)((size_t)u.pm * tstep); }
    __device__ __forceinline__ void a_ready(const Unit&) const {}
    __device__ __forceinline__ void done(const Unit&) const {}
};

__device__ __forceinline__ unsigned cvt_pk_bf16(float lo, float hi) { unsigned r; asm volatile("v_cvt_pk_bf16_f32 %0, %1, %2" : "=v"(r) : "v"(lo), "v"(hi)); return r; }
typedef float f32x2 __attribute__((ext_vector_type(2)));
__device__ __forceinline__ f32x2 gelu_pk(f32x2 v) {
    const f32x2 av = __builtin_elementwise_abs(v), d = av * 0.2316418882f + 1.0f;
    f32x2 t; t.x = __builtin_amdgcn_rcpf(d.x); t.y = __builtin_amdgcn_rcpf(d.y);
    f32x2 q = t * 0.5307027145f + (-0.7265760135f); q = q * t + 0.7107068705f; q = q * t + (-0.142248368f); q = q * t + 0.127414796f; q = q * t;
    const f32x2 s = (v * v) * (-0.72134752044f);
    f32x2 e; e.x = __builtin_amdgcn_exp2f(s.x); e.y = __builtin_amdgcn_exp2f(s.y);
    const f32x2 m = v * (q * e), r = v - m;
    f32x2 o; o.x = v.x < 0.f ? m.x : r.x; o.y = v.y < 0.f ? m.y : r.y; return o;
}

template <int ACT  > struct EpiBf16 {
    static constexpr bool PERM = true, AFTER_DRAIN = false; static_assert(ACT == 0 || ACT == 1, "EpiBf16: ACT is 0 (none) or 1 (gelu_pk)");
    bf16_t* O; int ldc; const float* bias; int split_cols; size_t split_stride; float scale0;
    __device__ __forceinline__ void operator()(const f32x4 (&acc)[2][2][4][2], const Unit& u, int wr, int wc, int fr, int fq) const {
        const int row0 = u.pm * BM + wr * 64 + fr; int colt = u.pn * BM; bf16_t* base = O;
        float sc = 1.f; if (split_cols) { const int t = colt / split_cols; base += (size_t)t * split_stride; colt -= t * split_cols; if (t == 0) sc = scale0; }
        const int col0 = colt + wc * 32 + 8 * fq, bcol0 = u.pn * BM + wc * 32 + 8 * fq;
        f32x4 bv[2][2];
#pragma unroll
        for (int bj = 0; bj < 2; ++bj)
#pragma unroll
            for (int n = 0; n < 2; ++n) bv[bj][n] = bias ? *(const f32x4*)(bias + bcol0 + bj * HALF + 4 * n) : (f32x4){0.f, 0.f, 0.f, 0.f};
#pragma unroll
        for (int ai = 0; ai < 2; ++ai)
#pragma unroll
            for (int m = 0; m < 4; ++m) { bf16_t* rowp = base + (size_t)(row0 + ai * HALF + m * 16) * ldc + col0;
#pragma unroll
                for (int bj = 0; bj < 2; ++bj) { f32x4 v0 = acc[ai][bj][m][0] + bv[bj][0], v1 = acc[ai][bj][m][1] + bv[bj][1];
                    if (ACT == 1) { f32x2 a = gelu_pk((f32x2){v0[0], v0[1]}), b = gelu_pk((f32x2){v0[2], v0[3]}), c = gelu_pk((f32x2){v1[0], v1[1]}), d = gelu_pk((f32x2){v1[2], v1[3]});
                        v0 = (f32x4){a.x, a.y, b.x, b.y}; v1 = (f32x4){c.x, c.y, d.x, d.y}; }
                    v0 = v0 * sc; v1 = v1 * sc; u32x4 w; w.x = cvt_pk_bf16(v0[0], v0[1]); w.y = cvt_pk_bf16(v0[2], v0[3]); w.z = cvt_pk_bf16(v1[0], v1[1]); w.w = cvt_pk_bf16(v1[2], v1[3]);
                    *(u32x4*)(rowp + bj * HALF) = w; } }
    }
};

struct PanelStats {
    unsigned* xbuf;
    unsigned* cnt;
    unsigned* tmo;
    int ntn; float eps;
    unsigned code;
    __device__ __forceinline__ bool run(const f32x4 (&v)[2][2][4][2], const Unit& u, int wr, int wc, int fr, int fq, PG8_LAS unsigned char* lds, int wid, int lane) const {
        typedef float f32x2v __attribute__((ext_vector_type(2)));
        PG8_LAS f32x2v* P = (PG8_LAS f32x2v*)lds;
        PG8_LAS f32x2v* S = (PG8_LAS f32x2v*)(lds + 8192);
        PG8_LAS unsigned* flag = (PG8_LAS unsigned*)(lds + 8192 + 2048);
#pragma unroll
        for (int ai = 0; ai < 2; ++ai)
#pragma unroll
            for (int m = 0; m < 4; ++m) {
                float s = 0.f;
#pragma unroll
                for (int bj = 0; bj < 2; ++bj)
#pragma unroll
                    for (int n = 0; n < 2; ++n) { const f32x4 x = v[ai][bj][m][n]; s += (x[0] + x[1]) + (x[2] + x[3]); }
                s += __shfl_xor(s, 16); s += __shfl_xor(s, 32);
                const float mw = s * (1.0f / 64.0f); float q = 0.f;
#pragma unroll
                for (int bj = 0; bj < 2; ++bj)
#pragma unroll
                    for (int n = 0; n < 2; ++n) { const f32x4 d = v[ai][bj][m][n] - mw; q += (d[0] * d[0] + d[1] * d[1]) + (d[2] * d[2] + d[3] * d[3]); }
                q += __shfl_xor(q, 16); q += __shfl_xor(q, 32);
                if (fq == 0) P[(ai * HALF + wr * 64 + m * 16 + fr) * 4 + wc] = (f32x2v){mw, q};
            }
        asm volatile("s_waitcnt lgkmcnt(0)" ::: "memory"); __builtin_amdgcn_s_barrier(); asm volatile("" ::: "memory");
#if defined(BROKEN_EXCHANGE_NO_WAIT)
#warning BROKEN CONTROL BUILD: the row-statistics exchange does not wait; results are wrong by design
        if (blockIdx.x >= 64) { const long long t0_ = clock64(); while (clock64() - t0_ < 60000) __builtin_amdgcn_s_sleep(8); }
#endif
        const int row = wid * 32 + (lane & 31);
        if (lane < 32) {
            const f32x2v a = P[row * 4 + 0], b = P[row * 4 + 1], c = P[row * 4 + 2], d = P[row * 4 + 3];
            const float mt = (a.x + b.x + c.x + d.x) * 0.25f;
            const float da = a.x - mt, db = b.x - mt, dc = c.x - mt, dd = d.x - mt;
            const float m2 = (a.y + b.y) + (c.y + d.y) + 64.0f * ((da * da + db * db) + (dc * dc + dd * dd));
            unsigned long long* slot = (unsigned long long*)xbuf + ((size_t)(u.pm * BM + row) * 4 + u.pn);
            __hip_atomic_store(slot, ((unsigned long long)__float_as_uint(m2) << 32) | __float_as_uint(mt), __ATOMIC_RELAXED, __HIP_MEMORY_SCOPE_AGENT);
        }
        asm volatile("s_waitcnt vmcnt(0)" ::: "memory");
        if (lane == 0) __hip_atomic_fetch_add(cnt + 64 * u.pm, 1u, __ATOMIC_RELAXED, __HIP_MEMORY_SCOPE_AGENT);
        if (wid == 0) {
            bool dead = false; const unsigned long long t0 = __builtin_amdgcn_s_memrealtime(); const unsigned want = 8u * (unsigned)ntn;
            for (;;) {
#if defined(BROKEN_EXCHANGE_NO_WAIT)
                break;
#endif
                if ((unsigned)__builtin_amdgcn_readfirstlane(__hip_atomic_load(cnt + 64 * u.pm, __ATOMIC_RELAXED, __HIP_MEMORY_SCOPE_AGENT)) >= want) break;
                if (__builtin_amdgcn_s_memrealtime() - t0 > 2000000ull) {
                    if (lane == 0) { unsigned expect = 0u; __hip_atomic_compare_exchange_strong(tmo + 1, &expect, code | (unsigned)(u.pm & 0xff), __ATOMIC_RELAXED, __ATOMIC_RELAXED, __HIP_MEMORY_SCOPE_AGENT);
                                     __hip_atomic_store(tmo, 1u, __ATOMIC_RELAXED, __HIP_MEMORY_SCOPE_AGENT); }
                    dead = true; break; }
                __builtin_amdgcn_s_sleep(2);
            }
            __builtin_amdgcn_fence(__ATOMIC_ACQUIRE, "agent");
            if (lane == 0) flag[0] = dead ? 1u : 0u;
        }
        asm volatile("s_waitcnt vmcnt(0) lgkmcnt(0)" ::: "memory"); __builtin_amdgcn_s_barrier(); asm volatile("" ::: "memory");
        const bool bad = flag[0] != 0u;
        if (lane < 32) {
            const unsigned long long* slot = (const unsigned long long*)xbuf + (size_t)(u.pm * BM + row) * 4; float mt[4], m2[4]; float ms = 0.f;
#pragma unroll
            for (int t = 0; t < 4; ++t) { if (t < ntn) { const unsigned long long w = __hip_atomic_load(slot + t, __ATOMIC_RELAXED, __HIP_MEMORY_SCOPE_AGENT); mt[t] = __uint_as_float((unsigned)w); m2[t] = __uint_as_float((unsigned)(w >> 32)); } else { mt[t] = 0.f; m2[t] = 0.f; } ms += mt[t]; }
            const float mean = ms / (float)ntn; float q = 0.f;
#pragma unroll
            for (int t = 0; t < 4; ++t) if (t < ntn) { const float dm = mt[t] - mean; q += m2[t] + 256.0f * dm * dm; }
            S[row] = (f32x2v){mean, 1.0f / sqrtf(q / (256.0f * (float)ntn) + eps)};
        }
        asm volatile("s_waitcnt lgkmcnt(0)" ::: "memory"); __builtin_amdgcn_s_barrier(); asm volatile("" ::: "memory");
        return bad;
    }
};
struct EpiLnRes {
    static constexpr bool PERM = false, AFTER_DRAIN = true;
    const float* base; float* out; int ldc; const float* bias; PanelStats st; unsigned poison;
    __device__ __forceinline__ void fused(f32x4 (&acc)[2][2][4][2], const Unit& u, int wr, int wc, int fr, int fq, PG8_LAS unsigned char* lds, int wid, int lane) const {
        typedef float f32x2v __attribute__((ext_vector_type(2)));
        const PG8_LAS f32x2v* S = (const PG8_LAS f32x2v*)(lds + 8192);
        const int col0 = u.pn * BM + wc * 32 + 4 * fq;
#pragma unroll
        for (int bj = 0; bj < 2; ++bj)
#pragma unroll
            for (int n = 0; n < 2; ++n) { const f32x4 bv = bias ? *(const f32x4*)(bias + col0 + bj * HALF + n * 16) : (f32x4){0.f, 0.f, 0.f, 0.f};
#pragma unroll
                for (int ai = 0; ai < 2; ++ai)
#pragma unroll
                    for (int m = 0; m < 4; ++m) acc[ai][bj][m][n] += bv; }
        f32x4 pre[4][2][2];
#pragma unroll
        for (int m = 0; m < 4; ++m) { const size_t off = (size_t)(u.pm * BM + wr * 64 + m * 16 + fr) * ldc + col0;
#pragma unroll
            for (int bj = 0; bj < 2; ++bj)
#pragma unroll
                for (int n = 0; n < 2; ++n) pre[m][bj][n] = *(const f32x4*)(base + off + bj * HALF + n * 16); }
        const bool bad = st.run(acc, u, wr, wc, fr, fq, lds, wid, lane) || poison != 0u;
        const float qnan = __builtin_nanf("");
#pragma unroll
        for (int ai = 0; ai < 2; ++ai)
#pragma unroll
            for (int m = 0; m < 4; ++m) { const int r = ai * HALF + wr * 64 + m * 16 + fr; const f32x2v sr = S[r]; const size_t off = (size_t)(u.pm * BM + r) * ldc + col0;
#pragma unroll
                for (int bj = 0; bj < 2; ++bj)
#pragma unroll
                    for (int n = 0; n < 2; ++n) { const f32x4 bs = ai == 0 ? pre[m][bj][n] : *(const f32x4*)(base + off + bj * HALF + n * 16); f32x4 o = bs + (acc[ai][bj][m][n] - sr.x) * sr.y;
                        if (bad) o = (f32x4){qnan, qnan, qnan, qnan}; *(f32x4*)(out + off + bj * HALF + n * 16) = o; }
                if (m & 1) asm volatile("" ::: "memory"); }
    }
};
struct EpiLnResLn {
    static constexpr bool PERM = false, AFTER_DRAIN = true;
    const float* base; float* out; bf16_t* xn; int ldc; const float* bias; PanelStats st1, st2; unsigned poison;
    __device__ __forceinline__ void fused(f32x4 (&acc)[2][2][4][2], const Unit& u, int wr, int wc, int fr, int fq, PG8_LAS unsigned char* lds, int wid, int lane) const {
        typedef float f32x2v __attribute__((ext_vector_type(2))); typedef unsigned u32x2v __attribute__((ext_vector_type(2)));
        const PG8_LAS f32x2v* S = (const PG8_LAS f32x2v*)(lds + 8192);
        const int col0 = u.pn * BM + wc * 32 + 4 * fq;
#pragma unroll
        for (int bj = 0; bj < 2; ++bj)
#pragma unroll
            for (int n = 0; n < 2; ++n) { const f32x4 bv = bias ? *(const f32x4*)(bias + col0 + bj * HALF + n * 16) : (f32x4){0.f, 0.f, 0.f, 0.f};
#pragma unroll
                for (int ai = 0; ai < 2; ++ai)
#pragma unroll
                    for (int m = 0; m < 4; ++m) acc[ai][bj][m][n] += bv; }
        bool bad = st1.run(acc, u, wr, wc, fr, fq, lds, wid, lane) || poison != 0u;
        const float qnan = __builtin_nanf("");
#pragma unroll
        for (int ai = 0; ai < 2; ++ai)
#pragma unroll
            for (int m = 0; m < 4; ++m) { const int r = ai * HALF + wr * 64 + m * 16 + fr; const f32x2v sr = S[r]; const size_t off = (size_t)(u.pm * BM + r) * ldc + col0;
#pragma unroll
                for (int bj = 0; bj < 2; ++bj)
#pragma unroll
                    for (int n = 0; n < 2; ++n) { const f32x4 bs = *(const f32x4*)(base + off + bj * HALF + n * 16); acc[ai][bj][m][n] = bs + (acc[ai][bj][m][n] - sr.x) * sr.y; }
                asm volatile("" : "+v"(acc[ai][0][m][0]), "+v"(acc[ai][0][m][1]), "+v"(acc[ai][1][m][0]), "+v"(acc[ai][1][m][1]));
                if (m & 1) asm volatile("" ::: "memory"); }
        const bool bad1 = bad;
        bad = st2.run(acc, u, wr, wc, fr, fq, lds, wid, lane) || bad;
#pragma unroll
        for (int ai = 0; ai < 2; ++ai)
#pragma unroll
            for (int m = 0; m < 4; ++m) { const int r = ai * HALF + wr * 64 + m * 16 + fr; const f32x2v sr = S[r]; const size_t off = (size_t)(u.pm * BM + r) * ldc + col0;
#pragma unroll
                for (int bj = 0; bj < 2; ++bj)
#pragma unroll
                    for (int n = 0; n < 2; ++n) { const f32x4 x1 = acc[ai][bj][m][n]; *(f32x4*)(out + off + bj * HALF + n * 16) = bad1 ? (f32x4){qnan, qnan, qnan, qnan} : x1;
                        const f32x4 o = (x1 - sr.x) * sr.y; u32x2v w; w.x = cvt_pk_bf16(o[0], o[1]); w.y = cvt_pk_bf16(o[2], o[3]);
                        if (bad) { w.x = 0x7fc07fc0u; w.y = 0x7fc07fc0u; } *(u32x2v*)(xn + off + bj * HALF + n * 16) = w; }
                asm volatile("" ::: "memory"); }
    }
};

template <class Epi, class Sched, bool ALIGN_EPI = false, bool SP2 = false>
__device__ __forceinline__ void gemm_phase(PG8_LAS unsigned char* lds, const Gemm g, const Sched& S, const Epi& E) {
    const int tid = threadIdx.x, wid = __builtin_amdgcn_readfirstlane(tid >> 6), lane = tid & 63, wr = wid >> 2, wc = wid & 3, fr = lane & 15, fq = lane >> 4;
    const int K = g.K, nt = K / BK;
    unsigned voffA[2], voffB[2];
#pragma unroll
    for (int i = 0; i < 2; ++i) { int R, C; stage_rc(tid * 16 + i * 8192, R, C); const int Rb = Epi::PERM ? ((R & ~31) + perm32(R & 31)) : R;
        voffA[i] = (unsigned)(R * K + C) * 2u; voffB[i] = (unsigned)(Rb * K + C) * 2u; }
    const size_t kstep = (size_t)(BK * 2);
    const size_t hstep = (size_t)HALF * K * 2;
    const size_t tstep = 2 * hstep;
    const unsigned ldsw = (unsigned)wid * 1024u;
    const int aoff = lds_byte(wr * 64 + fr, fq * 8), boff = lds_byte(wc * 32 + fr, fq * 8);
#define PG8_SA(b, h) (((b) * 2 + (h)) * HTB)
#define PG8_SB(b, h) ((4 + (b) * 2 + (h)) * HTB)
#define PG8_STAGE(bufoff, gbase, voff) do { _Pragma("unroll") for (int _i = 0; _i < 2; ++_i) \
        __builtin_amdgcn_global_load_lds((const unsigned*)((const char*)(gbase) + (voff)[_i]), (PG8_LAS unsigned*)(lds + (bufoff) + ldsw + _i * 8192), 16, 0, 0); } while (0)
#define PG8_LDA(dst, b, h) do { _Pragma("unroll") for (int m = 0; m < 4; ++m) _Pragma("unroll") for (int k = 0; k < 2; ++k) dst[m][k] = *(const PG8_LAS bf16x8*)(lds + PG8_SA(b, h) + aoff + m * 2048 + k * 1024); } while (0)
#define PG8_LDB(dst, b, h) do { _Pragma("unroll") for (int n = 0; n < 2; ++n) _Pragma("unroll") for (int k = 0; k < 2; ++k) dst[n][k] = *(const PG8_LAS bf16x8*)(lds + PG8_SB(b, h) + boff + n * 2048 + k * 1024); } while (0)
#define PG8_MMA(ai, bj, At, Bt) do { __builtin_amdgcn_s_setprio(1); _Pragma("unroll") for (int m = 0; m < 4; ++m) _Pragma("unroll") for (int n = 0; n < 2; ++n) _Pragma("unroll") for (int k = 0; k < 2; ++k) \
        acc[ai][bj][m][n] = __builtin_amdgcn_mfma_f32_16x16x32_bf16(Bt[n][k], At[m][k], acc[ai][bj][m][n], 0, 0, 0); __builtin_amdgcn_s_setprio(0); } while (0)
#define PG8_WAIT_V(n) asm volatile("s_waitcnt vmcnt(" #n ")" ::: "memory")
#define PG8_WAIT_L(n) asm volatile("s_waitcnt lgkmcnt(" #n ")" ::: "memory")
#define PG8_BAR __builtin_amdgcn_s_barrier()
#define PG8_SCHED __builtin_amdgcn_sched_barrier(0)
    Unit cur, nxt; int ui = 0;
    if (!S.next(0, cur)) return;
    f32x4 acc[2][2][4][2];
#pragma unroll
    for (int a = 0; a < 2; ++a)
#pragma unroll
        for (int b = 0; b < 2; ++b)
#pragma unroll
            for (int m = 0; m < 4; ++m)
#pragma unroll
                for (int n = 0; n < 2; ++n) acc[a][b][m][n] = (f32x4){0.f, 0.f, 0.f, 0.f};
    bf16x8 At[4][2], B0[2][2], B1[2][2];
    const char* cA = (const char*)g.A + S.a_off(cur, tstep); const char* cB = (const char*)g.Bt + (size_t)cur.pn * tstep;
    S.a_ready(cur);
    if constexpr (SP2) {
        PG8_STAGE(PG8_SB(0, 0), cB, voffB); PG8_STAGE(PG8_SB(0, 1), cB + hstep, voffB); PG8_STAGE(PG8_SA(0, 0), cA, voffA); PG8_STAGE(PG8_SA(0, 1), cA + hstep, voffA);
        if (wr == 1) PG8_BAR;
        PG8_WAIT_V(2); PG8_BAR;
        PG8_STAGE(PG8_SB(1, 0), cB + kstep, voffB); PG8_STAGE(PG8_SA(1, 0), cA + kstep, voffA); PG8_STAGE(PG8_SB(1, 1), cB + hstep + kstep, voffB);
        PG8_WAIT_V(6); PG8_BAR;
    } else {
        PG8_STAGE(PG8_SB(0, 0), cB, voffB); PG8_STAGE(PG8_SA(0, 0), cA, voffA); PG8_STAGE(PG8_SB(0, 1), cB + hstep, voffB); PG8_STAGE(PG8_SA(0, 1), cA + hstep, voffA);
        if (wr == 1) PG8_BAR;
        PG8_WAIT_V(4); PG8_BAR;
        PG8_STAGE(PG8_SB(1, 0), cB + kstep, voffB); PG8_STAGE(PG8_SA(1, 0), cA + kstep, voffA); PG8_STAGE(PG8_SB(1, 1), cB + hstep + kstep, voffB);
        PG8_WAIT_V(6); PG8_BAR;
    }
    for (;;) {
        const bool has_next = S.next(ui + 1, nxt);
        const char* nA = has_next ? (const char*)g.A + S.a_off(nxt, tstep) : cA; const char* nB = has_next ? (const char*)g.Bt + (size_t)nxt.pn * tstep : cB;
        for (int t = 0; t < nt; t += 2) {
            const bool last = (t == nt - 2);
            const char* a1 = cA + (size_t)(t + 1) * kstep;
            const char* a2 = last ? nA : cA + (size_t)(t + 2) * kstep; const char* b2 = last ? nB : cB + (size_t)(t + 2) * kstep;
            const char* a3 = a2 + kstep; const char* b3 = b2 + kstep;
            if (last && has_next) S.a_ready(nxt);
            if constexpr (SP2) {
            PG8_LDB(B0, 0, 0); PG8_LDB(B1, 0, 1); PG8_SCHED; PG8_LDA(At, 0, 0); PG8_STAGE(PG8_SA(1, 1), a1 + hstep, voffA);
            PG8_WAIT_V(8); PG8_WAIT_L(0); PG8_BAR; PG8_MMA(0, 0, At, B0); PG8_MMA(0, 1, At, B1); PG8_BAR; PG8_SCHED;
            PG8_LDA(At, 0, 1); PG8_STAGE(PG8_SB(0, 0), b2, voffB); PG8_STAGE(PG8_SB(0, 1), b2 + hstep, voffB); PG8_STAGE(PG8_SA(0, 0), a2, voffA);
            PG8_WAIT_V(8); PG8_WAIT_L(0); PG8_BAR; PG8_MMA(1, 0, At, B0); PG8_MMA(1, 1, At, B1); PG8_BAR; PG8_SCHED;
            PG8_LDB(B0, 1, 0); PG8_LDB(B1, 1, 1); PG8_SCHED; PG8_LDA(At, 1, 0); PG8_STAGE(PG8_SA(0, 1), a2 + hstep, voffA);
            PG8_WAIT_V(8); PG8_WAIT_L(0); PG8_BAR; PG8_MMA(0, 0, At, B0); PG8_MMA(0, 1, At, B1); PG8_BAR; PG8_SCHED;
            PG8_LDA(At, 1, 1); PG8_STAGE(PG8_SB(1, 0), b3, voffB); PG8_STAGE(PG8_SB(1, 1), b3 + hstep, voffB); PG8_STAGE(PG8_SA(1, 0), a3, voffA);
            PG8_WAIT_V(8); PG8_WAIT_L(0); PG8_BAR; PG8_MMA(1, 0, At, B0); PG8_MMA(1, 1, At, B1); PG8_BAR; PG8_SCHED;
            } else {
            PG8_LDB(B0, 0, 0); PG8_SCHED; PG8_LDA(At, 0, 0); PG8_STAGE(PG8_SA(1, 1), a1 + hstep, voffA);
            PG8_WAIT_L(8); PG8_BAR; PG8_WAIT_L(0); PG8_MMA(0, 0, At, B0); PG8_BAR; PG8_SCHED;
            PG8_LDB(B1, 0, 1); PG8_STAGE(PG8_SB(0, 0), b2, voffB);
            PG8_BAR; PG8_WAIT_L(0); PG8_MMA(0, 1, At, B1); PG8_BAR;
            PG8_LDA(At, 0, 1); PG8_STAGE(PG8_SA(0, 0), a2, voffA);
            PG8_BAR; PG8_WAIT_L(0); PG8_MMA(1, 0, At, B0); PG8_BAR; PG8_SCHED;
            PG8_STAGE(PG8_SB(0, 1), b2 + hstep, voffB);
            PG8_WAIT_V(6); PG8_BAR; PG8_MMA(1, 1, At, B1); PG8_BAR;
            PG8_LDB(B0, 1, 0); PG8_SCHED; PG8_LDA(At, 1, 0); PG8_STAGE(PG8_SA(0, 1), a2 + hstep, voffA);
            PG8_WAIT_L(8); PG8_BAR; PG8_WAIT_L(0); PG8_MMA(0, 0, At, B0); PG8_BAR; PG8_SCHED;
            PG8_LDB(B1, 1, 1); PG8_STAGE(PG8_SB(1, 0), b3, voffB);
            PG8_BAR; PG8_WAIT_L(0); PG8_MMA(0, 1, At, B1); PG8_BAR;
            PG8_LDA(At, 1, 1); PG8_STAGE(PG8_SA(1, 0), a3, voffA);
            PG8_BAR; PG8_WAIT_L(0); PG8_MMA(1, 0, At, B0); PG8_BAR; PG8_SCHED;
            PG8_STAGE(PG8_SB(1, 1), b3 + hstep, voffB);
            PG8_WAIT_V(6); PG8_BAR; PG8_MMA(1, 1, At, B1); PG8_BAR;
            }
        }
        if constexpr (ALIGN_EPI) { if (wr == 0) PG8_BAR; }
        if constexpr (!Epi::AFTER_DRAIN) { E(acc, cur, wr, wc, fr, fq); S.done(cur); }
        if (!has_next) break;
#pragma unroll
        for (int a = 0; a < 2; ++a)
#pragma unroll
            for (int b = 0; b < 2; ++b)
#pragma unroll
                for (int m = 0; m < 4; ++m)
#pragma unroll
                    for (int n = 0; n < 2; ++n) acc[a][b][m][n] = (f32x4){0.f, 0.f, 0.f, 0.f};
        cur = nxt; cA = nA; cB = nB; ++ui;
        if constexpr (ALIGN_EPI) { if (wr == 1) PG8_BAR; }
    }
    PG8_WAIT_V(0);
    if constexpr (!ALIGN_EPI) { if (wr == 0) PG8_BAR; }
    PG8_BAR;
    if constexpr (Epi::AFTER_DRAIN) { E.fused(acc, cur, wr, wc, fr, fq, lds, wid, lane); S.done(cur); }
#undef PG8_SA
#undef PG8_SB
#undef PG8_STAGE
#undef PG8_LDA
#undef PG8_LDB
#undef PG8_MMA
#undef PG8_WAIT_V
#undef PG8_WAIT_L
#undef PG8_BAR
#undef PG8_SCHED
}
}

#define LAS __attribute__((address_space(3)))
typedef unsigned short bf16;
typedef unsigned u32x4 __attribute__((ext_vector_type(4)));
typedef unsigned u32x2 __attribute__((ext_vector_type(2)));
typedef float f32x4 __attribute__((ext_vector_type(4)));
typedef float f32x2 __attribute__((ext_vector_type(2)));
typedef float f32x16 __attribute__((ext_vector_type(16)));
typedef short bf16x8 __attribute__((ext_vector_type(8)));
typedef short s16x4 __attribute__((ext_vector_type(4)));
typedef __bf16 bf16x2_t __attribute__((ext_vector_type(2)));
#define DI __device__ __forceinline__

DI unsigned pk2(float lo, float hi) { f32x2 v = {lo, hi}; bf16x2_t b = __builtin_convertvector(v, bf16x2_t); return __builtin_bit_cast(unsigned, b); }
DI float bflo(unsigned u) { return __uint_as_float(u << 16); }
DI float bfhi(unsigned u) { return __uint_as_float(u & 0xffff0000u); }
DI float wave_sum(float v) {
#pragma unroll
    for (int o = 1; o < 64; o <<= 1) v += __shfl_xor(v, o);
    return v;
}

constexpr int NB = 4, SEQ = 8192, DM = 1024, MROWS = NB * SEQ, DFF = 2816;
constexpr float LOG2E = 1.4426950408889634f;
constexpr float SC_A = 0.14724444602590306f;
constexpr float SC_64 = 0.18033688011112042f;
constexpr float ALPHA = 1.4142135623730951f;
constexpr int NWAVES = 8, NTHR = 512;
constexpr int LDS_BYTES = 147456;

constexpr size_t MiB = 1u << 20;
constexpr size_t WS_MOD = 0;
constexpr size_t WS_MISC = 256 * 1024;
constexpr size_t WS_BAR = 512 * 1024;
constexpr size_t WS_ROPE = 1 * MiB;
constexpr size_t WS_LF = 2 * MiB;
constexpr size_t WS_F = 3 * MiB;
constexpr size_t W_ABIN = 8 * MiB, W_UQ = 12 * MiB, W_UKV = 12 * MiB + 512 * 1024, W_ABOUT = 13 * MiB, W_CDIN = 15 * MiB, W_CDOUT = 21 * MiB;
constexpr size_t W_UP0 = 23 * MiB, W_UP1 = 34 * MiB, W_DN0 = 45 * MiB, W_DN1 = 51 * MiB;
constexpr size_t WS_U = 64 * MiB;
constexpr size_t WS_R1 = 128 * MiB, WS_R2 = 304 * MiB;
constexpr size_t WS_Y1 = WS_R1;
constexpr size_t WS_QA = 256 * MiB;
constexpr size_t WS_KV = 304 * MiB;
constexpr size_t WS_CQN = 368 * MiB, WS_CKVN = 384 * MiB, WS_KROPE = 392 * MiB;
constexpr size_t WS_G = WS_R1, WS_H = WS_R2;
constexpr size_t WS_QKV1 = WS_R1;
constexpr size_t WS_MRG1 = 320 * MiB;
constexpr size_t WS_END = 480 * MiB;

struct Params { const float* in[27]; float* out; unsigned char* ws; int lo, hi; };

__constant__ float INVF[16] = {1.0f, 0.5623413324356079f, 0.3162277638912201f, 0.17782793939113617f, 0.10000000149011612f, 0.05623413249850273f, 0.03162277489900589f,
    0.017782794311642647f, 0.009999999776482582f, 0.005623413249850273f, 0.003162277629598975f, 0.0017782794311642647f, 0.0010000000474974513f, 0.000562341301701963f,
    0.0003162277571391314f, 0.00017782794020604342f};

DI void tr_item(const float* W, int K, int Nsrc, int srccol0, bf16* WT, int n0, int k0, float sc, LAS float* scr, int lane) {
#pragma unroll 8
    for (int i = 0; i < 32; ++i) { const int kk = 2 * i + (lane >> 5);
        const float v = (srccol0 >= 0) ? W[(size_t)(k0 + kk) * Nsrc + srccol0 + (lane & 31)] : 0.f; scr[kk * 33 + (lane & 31)] = v * sc; }
    asm volatile("s_waitcnt lgkmcnt(0)" ::: "memory");
    const int c = lane & 7;
#pragma unroll
    for (int j = 0; j < 4; ++j) { const int n = (lane >> 3) + 8 * j; const LAS float* s = scr + (8 * c) * 33 + n;
        u32x4 o; o.x = pk2(s[0 * 33], s[1 * 33]); o.y = pk2(s[2 * 33], s[3 * 33]); o.z = pk2(s[4 * 33], s[5 * 33]); o.w = pk2(s[6 * 33], s[7 * 33]);
        *(u32x4*)(WT + (size_t)(n0 + n) * K + k0 + 8 * c) = o; }
    asm volatile("s_waitcnt lgkmcnt(0)" ::: "memory");
}

DI void p_prologue(const Params& p, LAS unsigned char* lds) {
    const int tid = threadIdx.x, lane = tid & 63, wave = tid >> 6, G = gridDim.x, bx = blockIdx.x;
    const float* c = p.in[1]; const float* ada_w = p.in[2]; const float* ada_b = p.in[3];
    float* MOD = (float*)(p.ws + WS_MOD);
    LAS float* cond = (LAS float*)lds;
    LAS float* red = (LAS float*)(lds + 16384);
    for (int i = tid; i < 4096; i += NTHR) { const float v = c[i]; cond[i] = v / (1.f + __expf(-v)); }
    __syncthreads();
    for (int it = bx; it < 192; it += G) {
        const int sub = it / 48, cb = it % 48, col = cb * 64 + lane;
        const float* w = ada_w + (size_t)sub * 1024 * 3072 + col;
        float a0 = 0.f, a1 = 0.f, a2 = 0.f, a3 = 0.f; const int kb = wave * 128;
#pragma unroll 8
        for (int k = 0; k < 128; ++k) { const float wv = w[(size_t)(kb + k) * 3072];
            a0 += cond[kb + k] * wv; a1 += cond[1024 + kb + k] * wv; a2 += cond[2048 + kb + k] * wv; a3 += cond[3072 + kb + k] * wv; }
        red[(wave * 4 + 0) * 64 + lane] = a0; red[(wave * 4 + 1) * 64 + lane] = a1; red[(wave * 4 + 2) * 64 + lane] = a2; red[(wave * 4 + 3) * 64 + lane] = a3;
        __syncthreads();
        if (tid < 256) { const int b = tid >> 6; float s = 0.f;
#pragma unroll
            for (int w8 = 0; w8 < 8; ++w8) s += red[(w8 * 4 + b) * 64 + lane];
            s += ada_b[sub * 3072 + col]; if (col >= 1024) s += 1.f;
            MOD[(sub * 4 + b) * 3072 + col] = s; }
        __syncthreads();
    }
    LAS float* scr = (LAS float*)(lds + 32768 + wave * 8448);
    const int gw = bx * NWAVES + wave, NGW = G * NWAVES;
    constexpr int NITEMS = 1024 + 96 + 64 + 512 + 1536 + 512 + 4 * 1408 + 2 * 1408;
    for (int it = gw; it < NITEMS; it += NGW) {
        int r = it; int job = 0;
        const int cnt[12] = {1024, 96, 64, 512, 1536, 512, 1408, 1408, 1408, 1408, 1408, 1408};
#pragma unroll
        for (int j = 0; j < 11; ++j) { if (job == j && r >= cnt[j]) { r -= cnt[j]; job = j + 1; } }
        const float* W; int K, Nsrc, Ndst; bf16* WT;
        switch (job) {
            case 0: W = p.in[7]; K = 1024; Nsrc = 1952; Ndst = 2048; WT = (bf16*)(p.ws + W_ABIN); break;
            case 1: W = p.in[9]; K = 256; Nsrc = 768; Ndst = 768; WT = (bf16*)(p.ws + W_UQ); break;
            case 2: W = p.in[11]; K = 128; Nsrc = 1024; Ndst = 1024; WT = (bf16*)(p.ws + W_UKV); break;
            case 3: W = p.in[17]; K = 1024; Nsrc = 1024; Ndst = 1024; WT = (bf16*)(p.ws + W_ABOUT); break;
            case 4: W = p.in[18]; K = 1024; Nsrc = 3080; Ndst = 3072; WT = (bf16*)(p.ws + W_CDIN); break;
            case 5: W = p.in[21]; K = 1024; Nsrc = 1024; Ndst = 1024; WT = (bf16*)(p.ws + W_CDOUT); break;
            case 6: W = p.in[22]; K = 1024; Nsrc = 2816; Ndst = 2816; WT = (bf16*)(p.ws + W_UP0); break;
            case 7: W = p.in[23]; K = 1024; Nsrc = 2816; Ndst = 2816; WT = (bf16*)(p.ws + W_UP0) + (size_t)128 * 1024; break;
            case 8: W = p.in[22] + (size_t)1024 * 2816; K = 1024; Nsrc = 2816; Ndst = 2816; WT = (bf16*)(p.ws + W_UP1); break;
            case 9: W = p.in[23] + (size_t)1024 * 2816; K = 1024; Nsrc = 2816; Ndst = 2816; WT = (bf16*)(p.ws + W_UP1) + (size_t)128 * 1024; break;
            case 10: W = p.in[26]; K = 2816; Nsrc = 1024; Ndst = 1024; WT = (bf16*)(p.ws + W_DN0); break;
            default: W = p.in[26] + (size_t)2816 * 1024; K = 2816; Nsrc = 1024; Ndst = 1024; WT = (bf16*)(p.ws + W_DN1); break;
        }
        const int nblk = Ndst / 32, kb = r / nblk, nb = r % nblk, n0 = nb * 32, k0 = kb * 64;
        int src = n0; float sc = 1.f;
        if (job == 0) { src = (n0 < 1952) ? n0 : -1; if (n0 >= 416 && n0 < 928) sc = SC_64; }
        else if (job == 1) { src = (n0 < 512) ? (n0 >> 6) * 96 + (n0 & 63) : ((n0 - 512) >> 5) * 96 + 64; sc = SC_A; }
        else if (job == 2) { src = (n0 < 512) ? (n0 >> 6) * 128 + (n0 & 63) : ((n0 - 512) >> 6) * 128 + 64 + ((n0 - 512) & 63); }
        else if (job == 4) { src = (n0 < 1536) ? n0 : n0 + 8; if (n0 < 512 || (n0 >= 1536 && n0 < 2048)) sc = SC_64; }
        int nd = n0;
        if (job >= 6 && job <= 9) nd = (n0 >> 7) * 256 + (n0 & 127);
        tr_item(W, K, Nsrc, src, WT, nd, k0, sc, scr, lane);
    }
    float* ROPE = (float*)(p.ws + WS_ROPE);
    for (int i = bx * NTHR + tid; i < SEQ * 16; i += G * NTHR) {
        const int pos = i >> 4, fi = i & 15;
        const float ang = (float)pos * INVF[fi];
        const double a = (double)ang, TWO_PI = 6.283185307179586476925;
        const double n = __builtin_rint(a * (1.0 / TWO_PI));
        const double x = a - n * TWO_PI, x2 = x * x;
        double sn = 1.0, cs = 1.0;
#pragma unroll
        for (int k = 13; k >= 1; --k) { sn = 1.0 - sn * x2 / (double)((2 * k) * (2 * k + 1)); cs = 1.0 - cs * x2 / (double)((2 * k - 1) * (2 * k)); }
        ROPE[i] = (float)cs; ROPE[SEQ * 16 + i] = (float)(sn * x);
    }
    if (bx == 0 && tid == 0) {
        float d1 = 0.f, d2 = 0.f;
        for (int i = 0; i < 64; ++i) { d1 += p.in[12][i] * p.in[13][i]; d2 += p.in[14][i] * p.in[15][i]; }
        ((float*)(p.ws + WS_MISC))[0] = expf(d1) - expf(d2) + 0.2f;
    }
}

DI void p_modulate(const Params& p) {
    const int tid = threadIdx.x, lane = tid & 63, wave = tid >> 6;
    const int gw = blockIdx.x * NWAVES + wave, NGW = gridDim.x * NWAVES;
    const float* x = p.in[0]; const float* MOD = (const float*)(p.ws + WS_MOD); bf16* U = (bf16*)(p.ws + WS_U);
    for (int row = gw; row < MROWS; row += NGW) {
        const int b = row >> 13; const float* mb = MOD + (size_t)b * 3072;
#pragma unroll
        for (int j = 0; j < 4; ++j) { const int col = 4 * lane + 256 * j;
            const f32x4 v = *(const f32x4*)(x + (size_t)row * DM + col), sh = *(const f32x4*)(mb + col), sc = *(const f32x4*)(mb + 1024 + col);
            const f32x4 u = v * sc + sh; u32x2 o; o.x = pk2(u[0], u[1]); o.y = pk2(u[2], u[3]);
            *(u32x2*)(U + (size_t)row * DM + col) = o; }
    }
}

DI void p_norm3(const Params& p) {
    const int tid = threadIdx.x, lane = tid & 63, wave = tid >> 6;
    const int gw = blockIdx.x * NWAVES + wave, NGW = gridDim.x * NWAVES;
    const bf16* Y1 = (const bf16*)(p.ws + WS_Y1); bf16* CQN = (bf16*)(p.ws + WS_CQN); bf16* CKVN = (bf16*)(p.ws + WS_CKVN); bf16* KR = (bf16*)(p.ws + WS_KROPE);
    const float* ROPE = (const float*)(p.ws + WS_ROPE);
    const f32x4 qg = *(const f32x4*)(p.in[8] + 4 * lane); const f32x2 kg = *(const f32x2*)(p.in[10] + 2 * lane);
    for (int row = gw; row < MROWS; row += NGW) {
        const bf16* yr = Y1 + (size_t)row * 2048;
        const u32x2 a = *(const u32x2*)(yr + 4 * lane); const unsigned kvv = *(const unsigned*)(yr + 256 + 2 * lane);
        float v0 = bflo(a.x), v1 = bfhi(a.x), v2 = bflo(a.y), v3 = bfhi(a.y);
        float ss = wave_sum(v0 * v0 + v1 * v1 + v2 * v2 + v3 * v3);
        float rs = 1.0f / sqrtf(ss * (1.f / 256.f) + 1e-6f);
        u32x2 o; o.x = pk2(v0 * rs * qg[0], v1 * rs * qg[1]); o.y = pk2(v2 * rs * qg[2], v3 * rs * qg[3]);
        *(u32x2*)(CQN + (size_t)row * 256 + 4 * lane) = o;
        float w0 = bflo(kvv), w1 = bfhi(kvv);
        ss = wave_sum(w0 * w0 + w1 * w1); rs = 1.0f / sqrtf(ss * (1.f / 128.f) + 1e-6f);
        *(unsigned*)(CKVN + (size_t)row * 128 + 2 * lane) = pk2(w0 * rs * kg[0], w1 * rs * kg[1]);
        if (lane < 16) { const int pos = row & (SEQ - 1);
            const float x1 = bflo((unsigned)yr[384 + lane]), x2 = bflo((unsigned)yr[400 + lane]);
            const float cs = ROPE[pos * 16 + lane], sn = ROPE[SEQ * 16 + pos * 16 + lane];
            KR[(size_t)row * 32 + lane] = (bf16)(pk2(x1 * cs - x2 * sn, 0.f) & 0xffffu);
            KR[(size_t)row * 32 + 16 + lane] = (bf16)(pk2(x1 * sn + x2 * cs, 0.f) & 0xffffu); }
    }
}

DI void p_ln(const Params& p, int lnidx, int next_sub, bool do_fl) {
    const int tid = threadIdx.x, lane = tid & 63, wave = tid >> 6;
    const int gw = blockIdx.x * NWAVES + wave, NGW = gridDim.x * NWAVES;
    float* X = p.out; const float* g = p.in[4] + lnidx * 1024; const float* bt = p.in[5] + lnidx * 1024;
    const float* MOD = (const float*)(p.ws + WS_MOD); bf16* U = (bf16*)(p.ws + WS_U);
    const float* wf = p.in[18] + 1536; const float* bfv = p.in[19]; float* LF = (float*)(p.ws + WS_LF);
    for (int row = gw; row < MROWS; row += NGW) {
        const int b = row >> 13;
        f32x4 v[4]; float s = 0.f;
#pragma unroll
        for (int j = 0; j < 4; ++j) { v[j] = *(const f32x4*)(X + (size_t)row * DM + 4 * lane + 256 * j); s += (v[j][0] + v[j][1]) + (v[j][2] + v[j][3]); }
        const float mean = wave_sum(s) * (1.f / 1024.f); float s2 = 0.f;
#pragma unroll
        for (int j = 0; j < 4; ++j) { v[j] = v[j] - mean; s2 += (v[j][0] * v[j][0] + v[j][1] * v[j][1]) + (v[j][2] * v[j][2] + v[j][3] * v[j][3]); }
        const float rstd = 1.0f / sqrtf(wave_sum(s2) * (1.f / 1024.f) + 1e-5f);
        float fa[8] = {0.f, 0.f, 0.f, 0.f, 0.f, 0.f, 0.f, 0.f};
#pragma unroll
        for (int j = 0; j < 4; ++j) { const int col = 4 * lane + 256 * j;
            const f32x4 xn = v[j] * rstd * *(const f32x4*)(g + col) + *(const f32x4*)(bt + col);
            *(f32x4*)(X + (size_t)row * DM + col) = xn;
            if (next_sub >= 0) { const float* mb = MOD + (size_t)(next_sub * 4 + b) * 3072;
                const f32x4 u = xn * *(const f32x4*)(mb + 1024 + col) + *(const f32x4*)(mb + col);
                u32x2 o; o.x = pk2(u[0], u[1]); o.y = pk2(u[2], u[3]); *(u32x2*)(U + (size_t)row * DM + col) = o;
                if (do_fl) {
#pragma unroll
                    for (int e = 0; e < 4; ++e) { const f32x4 w0 = *(const f32x4*)(wf + (size_t)(col + e) * 3080), w1 = *(const f32x4*)(wf + (size_t)(col + e) * 3080 + 4);
                        fa[0] += u[e] * w0[0]; fa[1] += u[e] * w0[1]; fa[2] += u[e] * w0[2]; fa[3] += u[e] * w0[3];
                        fa[4] += u[e] * w1[0]; fa[5] += u[e] * w1[1]; fa[6] += u[e] * w1[2]; fa[7] += u[e] * w1[3]; } } }
        }
        if (do_fl) {
#pragma unroll
            for (int h = 0; h < 8; ++h) fa[h] = wave_sum(fa[h]);
            if (lane < 8) {
                float xv = fa[0];
#pragma unroll
                for (int h = 1; h < 8; ++h) xv = (lane == h) ? fa[h] : xv;
                xv += bfv[lane];
                const float lf = fminf(xv, 0.f) - log1pf(expf(-fabsf(xv)));
                LF[(size_t)(b * 8 + lane) * SEQ + (row & (SEQ - 1))] = lf; }
        }
    }
}

DI void p_conv(const Params& p, int layer) {
    const bf16* Gb = (const bf16*)(p.ws + WS_G); bf16* Hb = (bf16*)(p.ws + WS_H);
    const float* cw = p.in[24] + (size_t)layer * 3 * DFF; const float* cbv = p.in[25] + (size_t)layer * DFF;
    const int total = (MROWS / 32) * (DFF / 8);
    for (int it = blockIdx.x * NTHR + threadIdx.x; it < total; it += gridDim.x * NTHR) {
        const int rb = it / (DFF / 8), ch = it % (DFF / 8), row0 = rb * 32, c0 = ch * 8;
        float w0[8], w1[8], w2[8], cb[8], gm2[8], gm1[8];
#pragma unroll
        for (int h = 0; h < 2; ++h) { const f32x4 a = *(const f32x4*)(cw + c0 + 4 * h), b = *(const f32x4*)(cw + DFF + c0 + 4 * h), c = *(const f32x4*)(cw + 2 * DFF + c0 + 4 * h), d = *(const f32x4*)(cbv + c0 + 4 * h);
#pragma unroll
            for (int e = 0; e < 4; ++e) { w0[4 * h + e] = a[e]; w1[4 * h + e] = b[e]; w2[4 * h + e] = c[e]; cb[4 * h + e] = d[e]; } }
        if ((row0 & (SEQ - 1)) == 0) {
#pragma unroll
            for (int e = 0; e < 8; ++e) { gm2[e] = 0.f; gm1[e] = 0.f; }
        } else {
            const u32x4 a = *(const u32x4*)(Gb + (size_t)(row0 - 2) * DFF + c0), b = *(const u32x4*)(Gb + (size_t)(row0 - 1) * DFF + c0);
#pragma unroll
            for (int e = 0; e < 4; ++e) { gm2[2 * e] = bflo(a[e]); gm2[2 * e + 1] = bfhi(a[e]); gm1[2 * e] = bflo(b[e]); gm1[2 * e + 1] = bfhi(b[e]); }
        }
#pragma unroll 4
        for (int r = 0; r < 32; ++r) {
            const size_t off = (size_t)(row0 + r) * DFF + c0;
            const u32x4 gv = *(const u32x4*)(Gb + off), vv = *(const u32x4*)(Hb + off);
            float g0[8], hv[8];
#pragma unroll
            for (int e = 0; e < 4; ++e) { g0[2 * e] = bflo(gv[e]); g0[2 * e + 1] = bfhi(gv[e]); }
#pragma unroll
            for (int e = 0; e < 8; ++e) { const float pre = w0[e] * gm2[e] + w1[e] * gm1[e] + w2[e] * g0[e] + cb[e];
                const float sl = pre * __builtin_amdgcn_rcpf(1.f + __expf(-pre)); const float vval = (e & 1) ? bfhi(vv[e >> 1]) : bflo(vv[e >> 1]);
                hv[e] = sl * vval; gm2[e] = gm1[e]; gm1[e] = g0[e]; }
            u32x4 o; o.x = pk2(hv[0], hv[1]); o.y = pk2(hv[2], hv[3]); o.z = pk2(hv[4], hv[5]); o.w = pk2(hv[6], hv[7]);
            *(u32x4*)(Hb + off) = o;
        }
    }
}

DI void p_scan(const Params& p, LAS unsigned char* lds) {
    if (blockIdx.x >= 32) return;
    const int tid = threadIdx.x, lane = tid & 63, wave = tid >> 6;
    const float* LF = (const float*)(p.ws + WS_LF) + (size_t)blockIdx.x * SEQ; float* F = (float*)(p.ws + WS_F) + (size_t)blockIdx.x * SEQ;
    LAS float* wsum = (LAS float*)lds;
    f32x4 v[4]; float s = 0.f;
#pragma unroll
    for (int j = 0; j < 4; ++j) { v[j] = *(const f32x4*)(LF + tid * 16 + 4 * j);
#pragma unroll
        for (int e = 0; e < 4; ++e) { s += v[j][e]; v[j][e] = s; } }
    float inc = s;
#pragma unroll
    for (int o = 1; o < 64; o <<= 1) { const float t = __shfl_up(inc, o); if (lane >= o) inc += t; }
    if (lane == 63) wsum[wave] = inc;
    __syncthreads();
    float off = inc - s;
#pragma unroll
    for (int w = 0; w < 8; ++w) off += (w < wave) ? wsum[w] : 0.f;
#pragma unroll
    for (int j = 0; j < 4; ++j) *(f32x4*)(F + tid * 16 + 4 * j) = v[j] + off;
    __syncthreads();
}

struct EpiResid {
    static constexpr bool PERM = true, AFTER_DRAIN = false;
    const float* xin; float* xout; const float* gate;
    __device__ __forceinline__ void operator()(const pg8::f32x4 (&acc)[2][2][4][2], const pg8::Unit& u, int wr, int wc, int fr, int fq) const {
        const int row0 = u.pm * 256 + wr * 64 + fr, col0 = u.pn * 256 + wc * 32 + 8 * fq, b = (u.pm * 256) >> 13;
        f32x4 gv[2][2];
#pragma unroll
        for (int bj = 0; bj < 2; ++bj)
#pragma unroll
            for (int n = 0; n < 2; ++n) gv[bj][n] = *(const f32x4*)(gate + (size_t)b * 3072 + col0 + bj * 128 + 4 * n);
#pragma unroll
        for (int ai = 0; ai < 2; ++ai)
#pragma unroll
            for (int m = 0; m < 4; ++m) { const size_t off = (size_t)(row0 + ai * 128 + m * 16) * DM + col0;
#pragma unroll
                for (int bj = 0; bj < 2; ++bj)
#pragma unroll
                    for (int n = 0; n < 2; ++n) { const f32x4 xi = *(const f32x4*)(xin + off + bj * 128 + 4 * n);
                        const f32x4 o = xi * ALPHA + gv[bj][n] * acc[ai][bj][m][n]; *(f32x4*)(xout + off + bj * 128 + 4 * n) = o; } }
    }
};

struct HaloOrder {
    int nwg, G, c;
    __device__ void init(int G_, int c_) { nwg = 132 * 22; G = G_; c = c_; }
    __device__ bool next(int i, pg8::Unit& u) const {
        const long L = (long)i * G + c; if (L >= nwg) return false;
        int wgid = (int)L; { const int q = nwg / 8, r = nwg % 8, xcd = wgid % 8, off = wgid / 8; wgid = (xcd < r ? xcd * (q + 1) : r * (q + 1) + (xcd - r) * q) + off; }
        const int nig = 8 * 22, gid = wgid / nig, fm = gid * 8, gsz = (132 - fm) < 8 ? (132 - fm) : 8;
        u.pm = fm + ((wgid % nig) % gsz); u.pn = (wgid % nig) / gsz; return true;
    }
    __device__ __forceinline__ long a_off(const pg8::Unit& u, size_t tstep) const { const int b = u.pm / 33, i = u.pm % 33; return ((long)b * SEQ + 254 * i - 2) * (long)(tstep / 256); }
    __device__ __forceinline__ void a_ready(const pg8::Unit&) const {}
    __device__ __forceinline__ void done(const pg8::Unit&) const {}
};
DI float dpp_ror1(float v) { return __int_as_float(__builtin_amdgcn_update_dpp(0, __float_as_int(v), 0x121, 0xf, 0xf, false)); }
DI float dpp_ror2(float v) { return __int_as_float(__builtin_amdgcn_update_dpp(0, __float_as_int(v), 0x122, 0xf, 0xf, false)); }
struct EpiConv {
    static constexpr bool PERM = true, AFTER_DRAIN = false;
    bf16* H; const float* cw; const float* cb; LAS float* halo;
    __device__ __forceinline__ void operator()(const pg8::f32x4 (&acc)[2][2][4][2], const pg8::Unit& u, int wr, int wc, int fr, int fq) const {
        const int b = u.pm / 33, ti = u.pm % 33, chl = wc * 32 + 8 * fq;
        if (fr >= 14) {
#pragma unroll
            for (int ai = 0; ai < 2; ++ai)
#pragma unroll
                for (int n = 0; n < 2; ++n) *(LAS f32x4*)(halo + ((2 * ai + wr) * 2 + (fr - 14)) * 128 + chl + 4 * n) = acc[ai][0][3][n];
        }
        asm volatile("s_waitcnt lgkmcnt(0)\n\ts_barrier" ::: "memory");
        f32x4 w0[2], w1[2], w2[2], cbv[2];
#pragma unroll
        for (int n = 0; n < 2; ++n) { const int ch = u.pn * 128 + chl + 4 * n;
            w0[n] = *(const f32x4*)(cw + ch); w1[n] = *(const f32x4*)(cw + DFF + ch); w2[n] = *(const f32x4*)(cw + 2 * DFF + ch); cbv[n] = *(const f32x4*)(cb + ch); }
#pragma unroll
        for (int ai = 0; ai < 2; ++ai) {
            const int blkid = 2 * ai + wr;
            f32x4 pr1[2], pr2[2];
#pragma unroll
            for (int n = 0; n < 2; ++n) {
                if (blkid > 0) { const LAS float* hp = halo + ((blkid - 1) * 2) * 128 + chl + 4 * n;
                    const f32x4 r62 = *(const LAS f32x4*)(hp), r63 = *(const LAS f32x4*)(hp + 128);
                    pr1[n] = r63; pr2[n] = (fr == 0) ? r62 : r63; }
                else { pr1[n] = (f32x4){0.f, 0.f, 0.f, 0.f}; pr2[n] = pr1[n]; }
            }
#pragma unroll
            for (int m = 0; m < 4; ++m) {
                const int lr = 128 * ai + 64 * wr + 16 * m + fr, t = 254 * ti + lr - 2;
                u32x4 outw;
#pragma unroll
                for (int n = 0; n < 2; ++n) {
                    f32x4 g = acc[ai][0][m][n];
                    if (ti == 0 && lr < 2) g = (f32x4){0.f, 0.f, 0.f, 0.f};
                    f32x4 a1, a2;
#pragma unroll
                    for (int e = 0; e < 4; ++e) { a1[e] = dpp_ror1(g[e]); a2[e] = dpp_ror2(g[e]); }
                    f32x4 p1, p2;
#pragma unroll
                    for (int e = 0; e < 4; ++e) { p1[e] = (fr >= 1) ? a1[e] : pr1[n][e]; p2[e] = (fr >= 2) ? a2[e] : pr2[n][e]; }
                    pr1[n] = a1; pr2[n] = a2;
                    const f32x4 pre = w0[n] * p2 + w1[n] * p1 + w2[n] * g + cbv[n];
                    const pg8::f32x4 vv = acc[ai][1][m][n];
                    f32x4 hv;
#pragma unroll
                    for (int e = 0; e < 4; ++e) hv[e] = pre[e] * __builtin_amdgcn_rcpf(1.f + __expf(-pre[e])) * vv[e];
                    outw[2 * n] = pk2(hv[0], hv[1]); outw[2 * n + 1] = pk2(hv[2], hv[3]);
                }
                if (lr >= 2 && t < SEQ) *(u32x4*)(H + (size_t)(b * SEQ + t) * DFF + u.pn * 128 + chl) = outw;
            }
        }
    }
};

namespace att {
constexpr int KBUF = 64 * 208, VBUF = 64 * 288;
constexpr int OFF_K = 0, OFF_V = 2 * KBUF, OFF_KB = 2 * KBUF + 2 * VBUF, OFF_TAB = OFF_KB + 512, LDS_END = OFF_TAB + 1024;
constexpr float NEG = -1e30f;
struct Src { const float* rope; const bf16* q; const bf16* q2; int qpitch; const bf16* k; const bf16* k2; int kpitch; const bf16* v; int vpitch; const float* f; float fref; };
#define MFMA32(a, b, c) __builtin_amdgcn_mfma_f32_32x32x16_bf16((a), (b), (c), 0, 0, 0)
typedef short v4i16_t __attribute__((ext_vector_type(4)));
DI s16x4 vtr(LAS unsigned char* ptr) { return __builtin_bit_cast(s16x4, __builtin_amdgcn_ds_read_tr16_b64_v4i16((LAS v4i16_t*)ptr)); }

template <int DQK, int DV, int MODE>
DI void core(LAS unsigned char* lds, const Src& s, int q0, int TLO, int THI, int tlo_w, int thi_w, int near_lo, float farc, f32x16 (&o)[DV / 32], float& l_out) {
    constexpr int KROW = DQK * 2 + 16, VROW = (DV == 128) ? 288 : 144, ND = DQK / 16, NC = DV / 32;
    const int tid = threadIdx.x, lane = tid & 63, r = lane & 31, h = lane >> 5;
    const int wid = __builtin_amdgcn_readfirstlane(tid >> 6);
    bf16x8 qf[ND];
    { const bf16* qp = s.q + (size_t)(q0 + 32 * wid + r) * s.qpitch + 8 * h;
#pragma unroll
      for (int d0 = 0; d0 < 4; ++d0) qf[d0] = *(const bf16x8*)(qp + 16 * d0);
      if constexpr (DQK == 96) { const bf16* q2p = s.q2 + (size_t)(q0 + 32 * wid + r) * s.qpitch + 8 * h;
          const u32x4 x1 = *(const u32x4*)(q2p), x2 = *(const u32x4*)(q2p + 16);
          const float* rp = s.rope + (size_t)(q0 + 32 * wid + r) * 16 + 8 * h;
          const f32x4 c0 = *(const f32x4*)(rp), c1 = *(const f32x4*)(rp + 4), s0 = *(const f32x4*)(rp + SEQ * 16), s1 = *(const f32x4*)(rp + SEQ * 16 + 4);
          u32x4 y1, y2;
#pragma unroll
          for (int e = 0; e < 4; ++e) { const float a0 = bflo(x1[e]), a1 = bfhi(x1[e]), b0 = bflo(x2[e]), b1 = bfhi(x2[e]);
              const float cl = e < 2 ? c0[2 * e] : c1[2 * e - 4], ch = e < 2 ? c0[2 * e + 1] : c1[2 * e - 3], sl = e < 2 ? s0[2 * e] : s1[2 * e - 4], sh = e < 2 ? s0[2 * e + 1] : s1[2 * e - 3];
              y1[e] = pk2(a0 * cl - b0 * sl, a1 * ch - b1 * sh); y2[e] = pk2(a0 * sl + b0 * cl, a1 * sh + b1 * ch); }
          qf[4] = __builtin_bit_cast(bf16x8, y1); qf[5] = __builtin_bit_cast(bf16x8, y2); } }
#pragma unroll
    for (int c = 0; c < NC; ++c)
#pragma unroll
        for (int i = 0; i < 16; ++i) o[c][i] = 0.f;
    float m_run = 0.f, l_run = 0.f;
    u32x4 kr, k2r, vr0, vr1; float fr_ = 0.f;
    kr = (u32x4){0u, 0u, 0u, 0u}; k2r = kr; vr0 = kr; vr1 = kr;
#define ATT_ISSUE(t) do { const size_t key0 = (size_t)(t) * 64; \
        kr = *(const u32x4*)(s.k + (key0 + (tid >> 3)) * s.kpitch + (tid & 7) * 8); \
        if constexpr (DQK == 96) { if (tid < 256) k2r = *(const u32x4*)(s.k2 + (key0 + (tid >> 2)) * 32 + (tid & 3) * 8); } \
        if constexpr (DV == 64) { vr0 = *(const u32x4*)(s.v + (key0 + (tid >> 3)) * s.vpitch + (tid & 7) * 8); } \
        else { vr0 = *(const u32x4*)(s.v + (key0 + (tid >> 4)) * s.vpitch + (tid & 15) * 8); vr1 = *(const u32x4*)(s.v + (key0 + 32 + (tid >> 4)) * s.vpitch + (tid & 15) * 8); } \
        if constexpr (MODE == 2) { if (tid < 64) fr_ = s.f[key0 + tid]; } } while (0)
#define ATT_COMMIT(buf) do { LAS unsigned char* kb_ = lds + OFF_K + (buf) * KBUF; LAS unsigned char* vb_ = lds + OFF_V + (buf) * VBUF; \
        *(LAS u32x4*)(kb_ + (tid >> 3) * KROW + (tid & 7) * 16) = kr; \
        if constexpr (DQK == 96) { if (tid < 256) *(LAS u32x4*)(kb_ + (tid >> 2) * KROW + 128 + (tid & 3) * 16) = k2r; } \
        if constexpr (DV == 64) { *(LAS u32x4*)(vb_ + (tid >> 3) * VROW + (tid & 7) * 16) = vr0; } \
        else { *(LAS u32x4*)(vb_ + (tid >> 4) * VROW + (tid & 15) * 16) = vr0; *(LAS u32x4*)(vb_ + (32 + (tid >> 4)) * VROW + (tid & 15) * 16) = vr1; } \
        if constexpr (MODE == 2) { if (tid < 64) ((LAS float*)(lds + OFF_KB))[(buf) * 64 + tid] = (s.fref - fr_) * LOG2E; } } while (0)
#define ATT_BAR() asm volatile("s_waitcnt lgkmcnt(0)\n\ts_barrier" ::: "memory")
    const int i16 = lane & 15, q4 = i16 >> 2, pp = i16 & 3, blk = (lane >> 4) & 1;
    const int voff = (4 * h + q4) * VROW + blk * 32 + pp * 8;
    bf16x8 pa[4];
    constexpr float THR = 8.f;
#define ATT_S1(t, buf) do { \
        LAS unsigned char* kb = lds + OFF_K + (buf) * KBUF; \
        f32x16 p0, p1; \
        if constexpr (MODE == 0) { _Pragma("unroll") for (int i = 0; i < 16; ++i) { p0[i] = -m_run; p1[i] = -m_run; } } \
        if constexpr (MODE == 1) { \
            if ((t) >= near_lo) { const LAS float* tab = (const LAS float*)(lds + OFF_TAB); const int base = (q0 + 32 * wid + r) - 64 * (t) + 63 - 4 * h; \
                _Pragma("unroll") for (int i = 0; i < 16; ++i) { const int kk = (i & 3) + 8 * (i >> 2); p0[i] = tab[base - kk] - m_run; p1[i] = tab[base - 32 - kk] - m_run; } } \
            else { const float c_ = farc - m_run; _Pragma("unroll") for (int i = 0; i < 16; ++i) { p0[i] = c_; p1[i] = c_; } } } \
        if constexpr (MODE == 2) { const LAS float* kbp = (const LAS float*)(lds + OFF_KB) + (buf) * 64; \
            _Pragma("unroll") for (int g = 0; g < 4; ++g) { const f32x4 b0 = *(const LAS f32x4*)(kbp + 8 * g + 4 * h), b1 = *(const LAS f32x4*)(kbp + 32 + 8 * g + 4 * h); \
                _Pragma("unroll") for (int e = 0; e < 4; ++e) { p0[4 * g + e] = b0[e] - m_run; p1[4 * g + e] = b1[e] - m_run; } } } \
        _Pragma("unroll") for (int d0 = 0; d0 < ND; ++d0) { \
            const bf16x8 k0 = *(const LAS bf16x8*)(kb + r * KROW + d0 * 32 + h * 16); \
            const bf16x8 k1 = *(const LAS bf16x8*)(kb + (32 + r) * KROW + d0 * 32 + h * 16); \
            p0 = MFMA32(k0, qf[d0], p0); p1 = MFMA32(k1, qf[d0], p1); } \
        if constexpr (MODE == 2) { if ((t) == thi_w) { const int qq = 32 * (wid & 1) + r; \
            _Pragma("unroll") for (int i = 0; i < 16; ++i) { const int kk = (i & 3) + 8 * (i >> 2) + 4 * h; if (kk > qq) p0[i] = NEG; if (kk + 32 > qq) p1[i] = NEG; } } } \
        float rm = fmaxf(fmaxf(p0[0], p0[1]), p1[0]); \
        _Pragma("unroll") for (int i = 2; i < 16; i += 2) rm = fmaxf(fmaxf(rm, p0[i]), p0[i + 1]); \
        _Pragma("unroll") for (int i = 1; i < 15; i += 2) rm = fmaxf(fmaxf(rm, p1[i]), p1[i + 1]); \
        rm = fmaxf(rm, p1[15]); \
        rm = fmaxf(rm, __shfl_xor(rm, 32)); \
        const bool first_ = ((t) == tlo_w); \
        if (first_ || __any(rm > THR)) { \
            const float dl = first_ ? rm : fmaxf(rm, 0.f); m_run += dl; \
            _Pragma("unroll") for (int i = 0; i < 16; ++i) { p0[i] -= dl; p1[i] -= dl; } \
            const float alpha = first_ ? 1.f : __builtin_amdgcn_exp2f(-dl); l_run *= alpha; \
            _Pragma("unroll") for (int c = 0; c < NC; ++c) _Pragma("unroll") for (int i = 0; i < 16; ++i) o[c][i] *= alpha; } \
        float rs0 = 0.f, rs1 = 0.f; \
        _Pragma("unroll") for (int i = 0; i < 16; ++i) { p0[i] = __builtin_amdgcn_exp2f(p0[i]); p1[i] = __builtin_amdgcn_exp2f(p1[i]); rs0 += p0[i]; rs1 += p1[i]; } \
        l_run += rs0 + rs1; \
        { u32x4 w; \
          w.x = pk2(p0[0], p0[1]); w.y = pk2(p0[2], p0[3]); w.z = pk2(p0[4], p0[5]); w.w = pk2(p0[6], p0[7]); pa[0] = __builtin_bit_cast(bf16x8, w); \
          w.x = pk2(p0[8], p0[9]); w.y = pk2(p0[10], p0[11]); w.z = pk2(p0[12], p0[13]); w.w = pk2(p0[14], p0[15]); pa[1] = __builtin_bit_cast(bf16x8, w); \
          w.x = pk2(p1[0], p1[1]); w.y = pk2(p1[2], p1[3]); w.z = pk2(p1[4], p1[5]); w.w = pk2(p1[6], p1[7]); pa[2] = __builtin_bit_cast(bf16x8, w); \
          w.x = pk2(p1[8], p1[9]); w.y = pk2(p1[10], p1[11]); w.z = pk2(p1[12], p1[13]); w.w = pk2(p1[14], p1[15]); pa[3] = __builtin_bit_cast(bf16x8, w); } \
    } while (0)
#define ATT_PV(buf) do { LAS unsigned char* vb = lds + OFF_V + (buf) * VBUF; \
        _Pragma("unroll") for (int c = 0; c < NC; ++c) _Pragma("unroll") for (int ks = 0; ks < 4; ++ks) { \
            const s16x4 lo = vtr(vb + voff + ks * 16 * VROW + c * 64), hi = vtr(vb + voff + ks * 16 * VROW + 8 * VROW + c * 64); \
            const bf16x8 vf = __builtin_shufflevector(lo, hi, 0, 1, 2, 3, 4, 5, 6, 7); \
            o[c] = MFMA32(vf, pa[ks], o[c]); if (NC == 4 && ks == 3) __builtin_amdgcn_sched_barrier(0); } } while (0)
    ATT_ISSUE(TLO); ATT_COMMIT(0);
    ATT_BAR();
    for (int t = TLO; t <= THI; ++t) {
        const int buf = (t - TLO) & 1;
        if (t < THI) ATT_ISSUE(t + 1);
        if (t >= tlo_w && t <= thi_w) { ATT_S1(t, buf); ATT_PV(buf); }
        if (t < THI) ATT_COMMIT(buf ^ 1);
        ATT_BAR();
    }
#undef ATT_ISSUE
#undef ATT_COMMIT
#undef ATT_S1
#undef ATT_PV
#undef ATT_BAR
    l_out = l_run + __shfl_xor(l_run, 32);
}

template <int DQK, int MODE>
DI void core2(LAS unsigned char* lds, const Src& s, int q0, int THI, int thi_w, f32x16 (&o)[2][2], float (&l_out)[2]) {
    constexpr int KROW = DQK * 2 + 16, VROW = 144, ND = DQK / 16;
    const int tid = threadIdx.x, lane = tid & 63, r = lane & 31, h = lane >> 5;
    const int wid = __builtin_amdgcn_readfirstlane(tid >> 6);
    bf16x8 qf[2][4];
    LAS unsigned char* qrl = lds + 65536 + (wid * 64 + r) * 80 + h * 16;
#pragma unroll
    for (int u = 0; u < 2; ++u) {
        const size_t qrow = (size_t)(q0 + 64 * wid + 32 * u + r);
        const bf16* qp = s.q + qrow * s.qpitch + 8 * h;
#pragma unroll
        for (int d0 = 0; d0 < 4; ++d0) qf[u][d0] = *(const bf16x8*)(qp + 16 * d0);
        if constexpr (DQK == 96) { const bf16* q2p = s.q2 + qrow * s.qpitch + 8 * h;
            const u32x4 x1 = *(const u32x4*)(q2p), x2 = *(const u32x4*)(q2p + 16);
            const float* rp = s.rope + qrow * 16 + 8 * h;
            const f32x4 c0 = *(const f32x4*)(rp), c1 = *(const f32x4*)(rp + 4), s0 = *(const f32x4*)(rp + SEQ * 16), s1 = *(const f32x4*)(rp + SEQ * 16 + 4);
            u32x4 y1, y2;
#pragma unroll
            for (int e = 0; e < 4; ++e) { const float a0 = bflo(x1[e]), a1 = bfhi(x1[e]), b0 = bflo(x2[e]), b1 = bfhi(x2[e]);
                const float cl = e < 2 ? c0[2 * e] : c1[2 * e - 4], ch = e < 2 ? c0[2 * e + 1] : c1[2 * e - 3], sl = e < 2 ? s0[2 * e] : s1[2 * e - 4], sh = e < 2 ? s0[2 * e + 1] : s1[2 * e - 3];
                y1[e] = pk2(a0 * cl - b0 * sl, a1 * ch - b1 * sh); y2[e] = pk2(a0 * sl + b0 * cl, a1 * sh + b1 * ch); }
            *(LAS u32x4*)(qrl + u * 32 * 80) = y1; *(LAS u32x4*)(qrl + u * 32 * 80 + 32) = y2; }
    }
#pragma unroll
    for (int u = 0; u < 2; ++u)
#pragma unroll
        for (int c = 0; c < 2; ++c)
#pragma unroll
            for (int i = 0; i < 16; ++i) o[u][c][i] = 0.f;
    float m_run[2] = {0.f, 0.f}, l_run[2] = {0.f, 0.f};
    u32x4 kr, k2r, vr0; float fr_ = 0.f;
    kr = (u32x4){0u, 0u, 0u, 0u}; k2r = kr; vr0 = kr;
#define ATT_ISSUE(t) do { const size_t key0 = (size_t)(t) * 64; \
        kr = *(const u32x4*)(s.k + (key0 + (tid >> 3)) * s.kpitch + (tid & 7) * 8); \
        if constexpr (DQK == 96) { if (tid < 256) k2r = *(const u32x4*)(s.k2 + (key0 + (tid >> 2)) * 32 + (tid & 3) * 8); } \
        vr0 = *(const u32x4*)(s.v + (key0 + (tid >> 3)) * s.vpitch + (tid & 7) * 8); \
        if constexpr (MODE == 2) { if (tid < 64) fr_ = s.f[key0 + tid]; } } while (0)
#define ATT_COMMIT(buf) do { LAS unsigned char* kb_ = lds + OFF_K + (buf) * KBUF; LAS unsigned char* vb_ = lds + OFF_V + (buf) * VBUF; \
        *(LAS u32x4*)(kb_ + (tid >> 3) * KROW + (tid & 7) * 16) = kr; \
        if constexpr (DQK == 96) { if (tid < 256) *(LAS u32x4*)(kb_ + (tid >> 2) * KROW + 128 + (tid & 3) * 16) = k2r; } \
        *(LAS u32x4*)(vb_ + (tid >> 3) * VROW + (tid & 7) * 16) = vr0; \
        if constexpr (MODE == 2) { if (tid < 64) ((LAS float*)(lds + OFF_KB))[(buf) * 64 + tid] = (s.fref - fr_) * LOG2E; } } while (0)
#define ATT_BAR() asm volatile("s_waitcnt lgkmcnt(0)\n\ts_barrier" ::: "memory")
    const int i16 = lane & 15, q4 = i16 >> 2, pp = i16 & 3, blk = (lane >> 4) & 1;
    const int voff = (4 * h + q4) * VROW + blk * 32 + pp * 8;
    constexpr float THR = 8.f;
    ATT_ISSUE(0); ATT_COMMIT(0);
    ATT_BAR();
    for (int t = 0; t <= THI; ++t) {
        const int buf = t & 1;
        if (t < THI) ATT_ISSUE(t + 1);
        if (t <= thi_w) {
            LAS unsigned char* kb = lds + OFF_K + buf * KBUF; LAS unsigned char* vb = lds + OFF_V + buf * VBUF;
            f32x16 p0[2], p1[2];
            if constexpr (MODE == 0) {
#pragma unroll
                for (int u = 0; u < 2; ++u)
#pragma unroll
                    for (int i = 0; i < 16; ++i) { p0[u][i] = -m_run[u]; p1[u][i] = -m_run[u]; }
            } else {
                const LAS float* kbp = (const LAS float*)(lds + OFF_KB) + buf * 64;
#pragma unroll
                for (int g = 0; g < 4; ++g) { const f32x4 b0 = *(const LAS f32x4*)(kbp + 8 * g + 4 * h), b1 = *(const LAS f32x4*)(kbp + 32 + 8 * g + 4 * h);
#pragma unroll
                    for (int u = 0; u < 2; ++u)
#pragma unroll
                        for (int e = 0; e < 4; ++e) { p0[u][4 * g + e] = b0[e] - m_run[u]; p1[u][4 * g + e] = b1[e] - m_run[u]; } }
            }
#pragma unroll
            for (int d0 = 0; d0 < ND; ++d0) {
                const bf16x8 k0 = *(const LAS bf16x8*)(kb + r * KROW + d0 * 32 + h * 16);
                const bf16x8 k1 = *(const LAS bf16x8*)(kb + (32 + r) * KROW + d0 * 32 + h * 16);
#pragma unroll
                for (int u = 0; u < 2; ++u) {
                    bf16x8 qv;
                    if (d0 < 4) qv = qf[u][d0 < 4 ? d0 : 0]; else qv = *(const LAS bf16x8*)(qrl + u * 32 * 80 + (d0 - 4) * 32);
                    p0[u] = MFMA32(k0, qv, p0[u]); p1[u] = MFMA32(k1, qv, p1[u]); }
                if (DQK == 96 && (d0 & 1)) __builtin_amdgcn_sched_barrier(0);
            }
            if constexpr (MODE == 2) { if (t == thi_w) {
#pragma unroll
                for (int u = 0; u < 2; ++u) { const int qq = 32 * u + r;
#pragma unroll
                    for (int i = 0; i < 16; ++i) { const int kk = (i & 3) + 8 * (i >> 2) + 4 * h; if (kk > qq) p0[u][i] = NEG; if (kk + 32 > qq) p1[u][i] = NEG; } } } }
            float rm[2];
#pragma unroll
            for (int u = 0; u < 2; ++u) {
                float a = fmaxf(fmaxf(p0[u][0], p0[u][1]), p0[u][2]), b = fmaxf(fmaxf(p1[u][0], p1[u][1]), p1[u][2]);
#pragma unroll
                for (int i = 3; i < 15; i += 2) { a = fmaxf(fmaxf(a, p0[u][i]), p0[u][i + 1]); b = fmaxf(fmaxf(b, p1[u][i]), p1[u][i + 1]); }
                a = fmaxf(fmaxf(a, p0[u][15]), fmaxf(b, p1[u][15]));
                rm[u] = fmaxf(a, __shfl_xor(a, 32));
            }
            const bool first_ = (t == 0);
            if (first_ || __any(fmaxf(rm[0], rm[1]) > THR)) {
#pragma unroll
                for (int u = 0; u < 2; ++u) {
                    const float dl = first_ ? rm[u] : fmaxf(rm[u], 0.f); m_run[u] += dl;
#pragma unroll
                    for (int i = 0; i < 16; ++i) { p0[u][i] -= dl; p1[u][i] -= dl; }
                    const float alpha = first_ ? 1.f : __builtin_amdgcn_exp2f(-dl); l_run[u] *= alpha;
#pragma unroll
                    for (int c = 0; c < 2; ++c)
#pragma unroll
                        for (int i = 0; i < 16; ++i) o[u][c][i] *= alpha;
                }
            }
            bf16x8 pa[2][4];
#pragma unroll
            for (int u = 0; u < 2; ++u) {
                float rs0 = 0.f, rs1 = 0.f, rs2 = 0.f, rs3 = 0.f;
#pragma unroll
                for (int i = 0; i < 16; i += 2) { p0[u][i] = __builtin_amdgcn_exp2f(p0[u][i]); p0[u][i + 1] = __builtin_amdgcn_exp2f(p0[u][i + 1]);
                    p1[u][i] = __builtin_amdgcn_exp2f(p1[u][i]); p1[u][i + 1] = __builtin_amdgcn_exp2f(p1[u][i + 1]);
                    rs0 += p0[u][i]; rs1 += p0[u][i + 1]; rs2 += p1[u][i]; rs3 += p1[u][i + 1]; }
                l_run[u] += (rs0 + rs1) + (rs2 + rs3);
                u32x4 w;
                w.x = pk2(p0[u][0], p0[u][1]); w.y = pk2(p0[u][2], p0[u][3]); w.z = pk2(p0[u][4], p0[u][5]); w.w = pk2(p0[u][6], p0[u][7]); pa[u][0] = __builtin_bit_cast(bf16x8, w);
                w.x = pk2(p0[u][8], p0[u][9]); w.y = pk2(p0[u][10], p0[u][11]); w.z = pk2(p0[u][12], p0[u][13]); w.w = pk2(p0[u][14], p0[u][15]); pa[u][1] = __builtin_bit_cast(bf16x8, w);
                w.x = pk2(p1[u][0], p1[u][1]); w.y = pk2(p1[u][2], p1[u][3]); w.z = pk2(p1[u][4], p1[u][5]); w.w = pk2(p1[u][6], p1[u][7]); pa[u][2] = __builtin_bit_cast(bf16x8, w);
                w.x = pk2(p1[u][8], p1[u][9]); w.y = pk2(p1[u][10], p1[u][11]); w.z = pk2(p1[u][12], p1[u][13]); w.w = pk2(p1[u][14], p1[u][15]); pa[u][3] = __builtin_bit_cast(bf16x8, w);
            }
#pragma unroll
            for (int c = 0; c < 2; ++c)
#pragma unroll
                for (int ks = 0; ks < 4; ++ks) {
                    const s16x4 lo = vtr(vb + voff + ks * 16 * VROW + c * 64), hi = vtr(vb + voff + ks * 16 * VROW + 8 * VROW + c * 64);
                    const bf16x8 vf = __builtin_shufflevector(lo, hi, 0, 1, 2, 3, 4, 5, 6, 7);
                    o[0][c] = MFMA32(vf, pa[0][ks], o[0][c]); o[1][c] = MFMA32(vf, pa[1][ks], o[1][c]);
                }
        }
        if (t < THI) ATT_COMMIT(buf ^ 1);
        ATT_BAR();
    }
#undef ATT_ISSUE
#undef ATT_COMMIT
#undef ATT_BAR
    l_out[0] = l_run[0] + __shfl_xor(l_run[0], 32); l_out[1] = l_run[1] + __shfl_xor(l_run[1], 32);
}

DI int t5_bucket(int rel) {
    const int n = rel < 0 ? -rel : rel; int b;
    if (n < 8) b = n; else if (n < 12) b = 8; else if (n < 16) b = 9; else if (n < 23) b = 10; else if (n < 32) b = 11; else if (n < 46) b = 12; else if (n < 64) b = 13; else if (n < 91) b = 14; else b = 15;
    return (rel > 0 ? 16 : 0) + b;
}
template <int NC> DI void store_o(const f32x16 (&o)[NC], float inv, bf16* O, int h) {
#pragma unroll
    for (int c = 0; c < NC; ++c)
#pragma unroll
        for (int g = 0; g < 4; ++g) { u32x2 w; w.x = pk2(o[c][4 * g] * inv, o[c][4 * g + 1] * inv); w.y = pk2(o[c][4 * g + 2] * inv, o[c][4 * g + 3] * inv);
            *(u32x2*)(O + 32 * c + 8 * g + 4 * h) = w; }
}

DI void phase_ab(const Params& p, LAS unsigned char* lds, int vcu, int G) {
    const int tid = threadIdx.x, lane = tid & 63, r = lane & 31, h = lane >> 5, wid = __builtin_amdgcn_readfirstlane(tid >> 6);
    const bf16* QA = (const bf16*)(p.ws + WS_QA); const bf16* KV = (const bf16*)(p.ws + WS_KV); const bf16* KR = (const bf16*)(p.ws + WS_KROPE);
    const bf16* Y1 = (const bf16*)(p.ws + WS_Y1); bf16* MRG = (bf16*)(p.ws + WS_U);
    for (int i = 0;; ++i) {
        const int idx = i * G + vcu; if (idx >= 1024) break;
        const int slot = idx >> 8, v = idx & 255, bh = v >> 3, sx = v & 7, b = bh >> 3, hd = bh & 7;
        const int qb = slot == 0 ? sx : slot == 1 ? 15 - sx : slot == 2 ? 16 + sx : 31 - sx;
        Src s; s.rope = (const float*)(p.ws + WS_ROPE); s.q = QA + (size_t)b * SEQ * 768 + hd * 64; s.q2 = QA + (size_t)b * SEQ * 768 + 512 + hd * 32; s.qpitch = 768;
        s.k = KV + (size_t)b * SEQ * 1024 + hd * 64; s.k2 = KR + (size_t)b * SEQ * 32; s.kpitch = 1024; s.v = KV + (size_t)b * SEQ * 1024 + 512 + hd * 64; s.vpitch = 1024; s.f = nullptr; s.fref = 0.f;
        f32x16 o[2]; float l;
        core<96, 64, 0>(lds, s, qb * 256, 0, 4 * qb + 3, 0, 4 * qb + (wid >> 1), 0, 0.f, o, l);
        store_o<2>(o, 1.0f / l, MRG + (size_t)(b * SEQ + qb * 256 + 32 * wid + r) * DM + hd * 64, h);
    }
    const float lam = ((const float*)(p.ws + WS_MISC))[0];
    for (int i = 0;; ++i) {
        const int idx = i * G + vcu; if (idx >= 512) break;
        const int slot = idx >> 8, v = idx & 255, bh = v >> 4, sx = v & 15, b = bh >> 2, hb = bh & 3;
        const int qb = slot == 0 ? sx : 31 - sx;
        if (tid < 255) ((LAS float*)(lds + OFF_TAB))[tid] = p.in[6][hb * 32 + t5_bucket(63 - tid)] * LOG2E;
        const float farc = p.in[6][hb * 32 + 15] * LOG2E;
        bf16* O = MRG + (size_t)(b * SEQ + qb * 256 + 32 * wid + r) * DM + 512 + hb * 128;
#pragma unroll
        for (int comp = 0; comp < 2; ++comp) {
            Src s; s.rope = nullptr; const bf16* yb = Y1 + (size_t)b * SEQ * 2048;
            s.q = yb + 416 + hb * 128 + comp * 64; s.q2 = nullptr; s.qpitch = 2048; s.k = yb + 928 + hb * 128 + comp * 64; s.k2 = nullptr; s.kpitch = 2048;
            s.v = yb + 1440 + hb * 128; s.vpitch = 2048; s.f = nullptr; s.fref = 0.f;
            f32x16 o[4]; float l; const int cw = 4 * qb + (wid >> 1);
            core<64, 128, 1>(lds, s, qb * 256, 0, 4 * qb + 3, 0, cw, cw - 2, farc, o, l);
            const float inv = 1.0f / l;
            if (comp == 0) {
                store_o<4>(o, inv, O, h);
            } else {
                const float li = lam * inv; float ss = 0.f;
#pragma unroll
                for (int c = 0; c < 4; ++c)
#pragma unroll
                    for (int g = 0; g < 4; ++g) { const u32x2 w0 = *(const u32x2*)(O + 32 * c + 8 * g + 4 * h);
                        o[c][4 * g] = bflo(w0.x) - li * o[c][4 * g]; o[c][4 * g + 1] = bfhi(w0.x) - li * o[c][4 * g + 1];
                        o[c][4 * g + 2] = bflo(w0.y) - li * o[c][4 * g + 2]; o[c][4 * g + 3] = bfhi(w0.y) - li * o[c][4 * g + 3];
                        ss += (o[c][4 * g] * o[c][4 * g] + o[c][4 * g + 1] * o[c][4 * g + 1]) + (o[c][4 * g + 2] * o[c][4 * g + 2] + o[c][4 * g + 3] * o[c][4 * g + 3]); }
                ss += __shfl_xor(ss, 32);
                const float rstd = 0.8f / sqrtf(ss * (1.f / 128.f) + 1e-6f);
#pragma unroll
                for (int c = 0; c < 4; ++c)
#pragma unroll
                    for (int g = 0; g < 4; ++g) { const f32x4 sg = *(const f32x4*)(p.in[16] + 32 * c + 8 * g + 4 * h);
                        u32x2 w; w.x = pk2(o[c][4 * g] * rstd * sg[0], o[c][4 * g + 1] * rstd * sg[1]); w.y = pk2(o[c][4 * g + 2] * rstd * sg[2], o[c][4 * g + 3] * rstd * sg[3]);
                        *(u32x2*)(O + 32 * c + 8 * g + 4 * h) = w; }
            }
        }
    }
}

DI void phase_cd(const Params& p, LAS unsigned char* lds, int vcu, int G) {
    const int tid = threadIdx.x, lane = tid & 63, r = lane & 31, h = lane >> 5, wid = __builtin_amdgcn_readfirstlane(tid >> 6);
    const bf16* QKV = (const bf16*)(p.ws + WS_QKV1); bf16* MRG = (bf16*)(p.ws + WS_MRG1); const float* F = (const float*)(p.ws + WS_F);
    for (int i = 0;; ++i) {
        const int idx = i * G + vcu; if (idx >= 512) break;
        const int slot = idx >> 8, v = idx & 255, bh = v >> 3, sx = v & 7, b = bh >> 3, hd = bh & 7;
        const int qb = slot == 0 ? sx : 15 - sx;
        const bf16* yb = QKV + (size_t)b * SEQ * 3072;
        Src s; s.rope = nullptr; s.q = yb + hd * 64; s.q2 = nullptr; s.qpitch = 3072; s.k = yb + 512 + hd * 64; s.k2 = nullptr; s.kpitch = 3072; s.v = yb + 1024 + hd * 64; s.vpitch = 3072;
        s.f = F + (size_t)bh * SEQ; s.fref = s.f[qb * 512];
        f32x16 o[2][2]; float l[2];
        core2<64, 2>(lds, s, qb * 512, 8 * qb + 7, 8 * qb + wid, o, l);
#pragma unroll
        for (int u = 0; u < 2; ++u) store_o<2>(o[u], 1.0f / l[u], MRG + (size_t)(b * SEQ + qb * 512 + 64 * wid + 32 * u + r) * DM + hd * 64, h);
    }
    for (int i = 0;; ++i) {
        const int idx = i * G + vcu; if (idx >= 1024) break;
        const int slot = idx >> 8, v = idx & 255, bh = v >> 3, sx = v & 7, b = bh >> 3, hd = bh & 7;
        const int qb = 4 * sx + slot;
        const float* rt = p.in[20] + hd * 257;
        if (tid < 255) { int d = tid - 63; d = d < -128 ? -128 : (d > 128 ? 128 : d); ((LAS float*)(lds + OFF_TAB))[tid] = rt[d + 128] * LOG2E; }
        const float farc = rt[256] * LOG2E;
        const bf16* yb = QKV + (size_t)b * SEQ * 3072;
        Src s; s.rope = nullptr; s.q = yb + 1536 + hd * 64; s.q2 = nullptr; s.qpitch = 3072; s.k = yb + 2048 + hd * 64; s.k2 = nullptr; s.kpitch = 3072; s.v = yb + 2560 + hd * 64; s.vpitch = 3072; s.f = nullptr; s.fref = 0.f;
        f32x16 o[2]; float l; const int cw = 4 * qb + (wid >> 1);
        const int TLO = (4 * qb - 8) > 0 ? (4 * qb - 8) : 0, tlo_w = (cw - 8) > 0 ? (cw - 8) : 0;
        core<64, 64, 1>(lds, s, qb * 256, TLO, 4 * qb + 3, tlo_w, cw, cw - 2, farc, o, l);
        store_o<2>(o, 1.0f / l, MRG + (size_t)(b * SEQ + qb * 256 + 32 * wid + r) * DM + 512 + hd * 64, h);
    }
}
}

#define XB_TMO      128
#define XB_XCNT(j)  (256  + 64 * (j))
#define XB_XSUB(j)  (1280 + 64 * (j))
#define XB_XGEN(j)  (2304 + 64 * (j))
#define XB_TOP      3328
#define XB_TOPGEN   3392
#define XCD_BAR_WORDS 3456
#define XB_SPIN_CAP (1u << 18)

__device__ __forceinline__ unsigned xb_ld(unsigned* p)              { return __hip_atomic_load(p, __ATOMIC_RELAXED, __HIP_MEMORY_SCOPE_AGENT); }
__device__ __forceinline__ unsigned xb_add(unsigned* p, unsigned v) { return __hip_atomic_fetch_add(p, v, __ATOMIC_RELAXED, __HIP_MEMORY_SCOPE_AGENT); }
__device__ __forceinline__ unsigned xb_xcc_id() { return (unsigned)__builtin_amdgcn_s_getreg((3 << 11) | 20) & 0xFu; }
#define XB_SPIN(cond, bar) do { unsigned _sp = 0; while (cond) { __builtin_amdgcn_s_sleep(1); \
    if ((++_sp & 255u) == 0u) { if (xb_ld(&(bar)[XB_TMO])) break; if (_sp > XB_SPIN_CAP) { atomicAdd(&(bar)[XB_TMO], 1u); break; } } } } while (0)

struct XcdBarrier {
    unsigned* bar; unsigned x;
    volatile LAS unsigned* st;
};

__device__ __forceinline__ XcdBarrier xcd_barrier_post(unsigned* bar, volatile LAS unsigned* st) {
    XcdBarrier b; b.bar = bar; b.x = xb_xcc_id(); b.st = st;
    if (threadIdx.x == 0) (void)xb_add(&bar[XB_XCNT(b.x)], 1u);
    return b;
}
__device__ __forceinline__ void xcd_barrier_complete(unsigned* bar, unsigned x, unsigned& nloc, unsigned& nx) {
    const unsigned G = gridDim.x * gridDim.y * gridDim.z;
    unsigned sum, cnt, mine, sp = 0u;
    for (;;) {
        sum = 0u; cnt = 0u; mine = 0u;
#pragma unroll
        for (unsigned j = 0; j < 16; ++j) { const unsigned c = xb_ld(&bar[XB_XCNT(j)]); sum += c; cnt += (c > 0u) ? 1u : 0u; mine = (j == x) ? c : mine; }
        if (sum == G) break;
        __builtin_amdgcn_s_sleep(1);
        if ((++sp & 255u) == 0u) { if (xb_ld(&bar[XB_TMO])) break; if (sp > XB_SPIN_CAP) { atomicAdd(&bar[XB_TMO], 1u); break; } }
    }
    nloc = mine > 0u ? mine : 1u; nx = cnt > 0u ? cnt : 1u;
}

__device__ __forceinline__ void xcd_barrier(const XcdBarrier& b) {
    asm volatile("s_waitcnt vmcnt(0)" ::: "memory");
    __syncthreads();
    if (threadIdx.x == 0) {
        unsigned* bar = b.bar;
        __builtin_amdgcn_s_waitcnt(0);
        unsigned nloc = b.st[0], nx = b.st[1];
        if (nloc == 0u) { xcd_barrier_complete(bar, b.x, nloc, nx); b.st[0] = nloc; b.st[1] = nx; }
        const unsigned old = xb_add(&bar[XB_XSUB(b.x)], 1u);
        const unsigned gen = old / nloc;
        if (old + 1u == (gen + 1u) * nloc) {
            __builtin_amdgcn_fence(__ATOMIC_RELEASE, "agent");
            asm volatile("s_waitcnt vmcnt(0)" ::: "memory");
            const unsigned og = xb_add(&bar[XB_TOP], 1u);
            const unsigned tg = og / nx;
            if (og + 1u == (tg + 1u) * nx) xb_add(&bar[XB_TOPGEN], 1u);
            else XB_SPIN(xb_ld(&bar[XB_TOPGEN]) == tg, bar);
            __builtin_amdgcn_fence(__ATOMIC_ACQUIRE, "agent");
            xb_add(&bar[XB_XGEN(b.x)], 1u);
            asm volatile("s_waitcnt vmcnt(0)" ::: "memory");
        } else {
            XB_SPIN(xb_ld(&bar[XB_XGEN(b.x)]) == gen, bar);
            __builtin_amdgcn_fence(__ATOMIC_ACQUIRE, "agent");
            asm volatile("s_waitcnt vmcnt(0)" ::: "memory");
        }
    }
    __syncthreads();
}

constexpr int NPHASE = 20;
__global__ void __launch_bounds__(NTHR, 2) mega_fwd(Params p) {
    extern __shared__ __attribute__((aligned(16))) unsigned char lds_raw[];
    LAS unsigned char* lds = (LAS unsigned char*)lds_raw;
    cg::grid_group grid = cg::this_grid();
    const int G = gridDim.x, bx = blockIdx.x;
    const int vcu = (G % 8 == 0) ? (bx % 8) * (G / 8) + bx / 8 : bx;
    unsigned char* ws = p.ws;
    const float* MOD = (const float*)(ws + WS_MOD);
    typedef pg8::EpiBf16<0> EpiSt;
    volatile LAS unsigned* MISC = (volatile LAS unsigned*)(lds + 131072 + 512);
    if (threadIdx.x < 2) MISC[threadIdx.x] = 0u;
    __syncthreads();
    const XcdBarrier bar = xcd_barrier_post((unsigned*)(ws + WS_BAR), MISC);
#define IN(k) (p.lo <= (k) && (k) < p.hi)
#define SEAM(k) do { if (IN(k) && IN((k) + 1)) { if ((k) == 0) grid.sync(); else xcd_barrier(bar); } } while (0)
#define STORE_GEMM(Aoff, Woff, N_, K_, Ooff, ldc_, splitc, splits) do { \
        pg8::Gemm g{(const pg8::bf16_t*)(ws + (Aoff)), (const pg8::bf16_t*)(ws + (Woff)), MROWS, (N_), (K_)}; \
        EpiSt E{(pg8::bf16_t*)(ws + (Ooff)), (ldc_), nullptr, (splitc), (splits), 1.f}; \
        pg8::StaticOrder S; S.init(MROWS, (N_), G, bx); \
        pg8::gemm_phase<EpiSt, pg8::StaticOrder, true, true>(lds, g, S, E); } while (0)
#define UP_GEMM(Woff, layer_) do { \
        pg8::Gemm g{(const pg8::bf16_t*)(ws + WS_U), (const pg8::bf16_t*)(ws + (Woff)), MROWS, 2 * DFF, 1024}; \
        EpiConv E{(bf16*)(ws + WS_H), p.in[24] + (size_t)(layer_) * 3 * DFF, p.in[25] + (size_t)(layer_) * DFF, (LAS float*)(lds + 131072 + 1024)}; \
        HaloOrder S; S.init(G, bx); \
        pg8::gemm_phase<EpiConv, HaloOrder, true, true>(lds, g, S, E); } while (0)
#define RESID_GEMM(Aoff, Woff, K_, xin_, sub) do { \
        pg8::Gemm g{(const pg8::bf16_t*)(ws + (Aoff)), (const pg8::bf16_t*)(ws + (Woff)), MROWS, 1024, (K_)}; \
        EpiResid E{(xin_), p.out, MOD + (sub) * 4 * 3072 + 2048}; \
        pg8::StaticOrder S; S.init(MROWS, 1024, G, bx); \
        pg8::gemm_phase<EpiResid, pg8::StaticOrder, true, true>(lds, g, S, E); } while (0)
    if (IN(0)) p_prologue(p, lds);
    SEAM(0);
    if (IN(1)) p_modulate(p);
    SEAM(1);
    if (IN(2)) STORE_GEMM(WS_U, W_ABIN, 2048, 1024, WS_Y1, 2048, 0, 0);
    SEAM(2);
    if (IN(3)) p_norm3(p);
    SEAM(3);
    if (IN(4)) {
        STORE_GEMM(WS_CQN, W_UQ, 768, 256, WS_QA, 768, 0, 0);
        STORE_GEMM(WS_CKVN, W_UKV, 1024, 128, WS_KV, 1024, 0, 0);
    }
    SEAM(4);
    if (IN(5)) att::phase_ab(p, lds, vcu, G);
    SEAM(5);
    if (IN(6)) RESID_GEMM(WS_U, W_ABOUT, 1024, p.in[0], 0);
    SEAM(6);
    if (IN(7)) p_ln(p, 0, 1, false);
    SEAM(7);
    if (IN(8)) UP_GEMM(W_UP0, 0);
    SEAM(8);
    if (IN(10)) RESID_GEMM(WS_H, W_DN0, DFF, p.out, 1);
    SEAM(10);
    if (IN(11)) p_ln(p, 1, 2, true);
    SEAM(11);
    if (IN(12)) { p_scan(p, lds); STORE_GEMM(WS_U, W_CDIN, 3072, 1024, WS_QKV1, 3072, 0, 0); }
    SEAM(12);
    if (IN(13)) att::phase_cd(p, lds, vcu, G);
    SEAM(13);
    if (IN(14)) RESID_GEMM(WS_MRG1, W_CDOUT, 1024, p.out, 2);
    SEAM(14);
    if (IN(15)) p_ln(p, 2, 3, false);
    SEAM(15);
    if (IN(16)) UP_GEMM(W_UP1, 1);
    SEAM(16);
    if (IN(18)) RESID_GEMM(WS_H, W_DN1, DFF, p.out, 3);
    SEAM(18);
    if (IN(19)) p_ln(p, 3, -1, false);
}

extern "C" void kernel_launch(void* const* d_in, const int* in_sizes, int n_in, void* d_out, int out_size, void* d_ws, size_t ws_size, hipStream_t stream) {
    static int grid = 0;
    if (grid == 0) {
        if (n_in != 27 || out_size != MROWS * DM || ws_size < WS_END) { fprintf(stderr, "kernel_launch: unexpected shapes (n_in %d out %d ws %zu)\n", n_in, out_size, ws_size); grid = -1; return; }
        int dev = 0, cus = 0, per_cu = 0;
        (void)hipGetDevice(&dev); (void)hipDeviceGetAttribute(&cus, hipDeviceAttributeMultiprocessorCount, dev);
        if (hipFuncSetAttribute((const void*)mega_fwd, hipFuncAttributeMaxDynamicSharedMemorySize, LDS_BYTES) != hipSuccess) { fprintf(stderr, "kernel_launch: hipFuncSetAttribute failed\n"); grid = -1; return; }
        if (hipOccupancyMaxActiveBlocksPerMultiprocessor(&per_cu, (const void*)mega_fwd, NTHR, LDS_BYTES) != hipSuccess || per_cu < 1) { fprintf(stderr, "kernel_launch: occupancy query says %d\n", per_cu); per_cu = 1; }
        (void)hipGetLastError();
        grid = cus;
    }
    if (grid < 0) return;
    Params a{};
    for (int i = 0; i < 27; ++i) a.in[i] = (const float*)d_in[i];
    a.out = (float*)d_out; a.ws = (unsigned char*)d_ws; a.lo = 0; a.hi = NPHASE;
    if (hipMemsetAsync((char*)d_ws + WS_BAR, 0, 16384, stream) != hipSuccess) { fprintf(stderr, "kernel_launch: memset failed\n"); return; }
    void* args[] = {&a};
    hipError_t e = hipLaunchCooperativeKernel((const void*)mega_fwd, dim3(grid), dim3(NTHR), args, LDS_BYTES, stream);
    if (e != hipSuccess) fprintf(stderr, "cooperative launch failed: %s (grid %d)\n", hipGetErrorString(e), grid);
}
```
